# Optimizing an MI355X kernel written in HIP

```python
import math
import jax, jax.numpy as jnp
from jax import lax
import numpy as np

D_MODEL = 1024
BATCH = 1
SEQ = 16384
DEPTH = 1

CHUNK = 64
Q_BLOCK = 128
HEAD_DIM = 64
N_HEADS_FOX = 8
WIDTH_FOX = N_HEADS_FOX * HEAD_DIM
N_HEADS_DIFF = 4
DIFF_V_DIM = 2 * HEAD_DIM
WIDTH_DIFF = N_HEADS_DIFF * DIFF_V_DIM
WIDTH_DIFF_QK = 2 * N_HEADS_DIFF * HEAD_DIM
MIX_WIDTH = WIDTH_FOX + WIDTH_DIFF
COL_SIZES = (WIDTH_FOX, WIDTH_FOX, WIDTH_FOX, WIDTH_FOX, N_HEADS_FOX,
             WIDTH_DIFF_QK, WIDTH_DIFF_QK, WIDTH_DIFF, WIDTH_DIFF)
IN_COLS = 4 * WIDTH_FOX + N_HEADS_FOX + 2 * WIDTH_DIFF_QK + 2 * WIDTH_DIFF
ROPE_THETA = 10000.0
EPS = 1e-6
FORGET_BIAS_OFFSET = 3.0

kernel_name = "hymba_fox_diffattn_streaming_block"


def rms_norm(x, g):
    xf = x.astype(jnp.float32)
    y = xf * lax.rsqrt(jnp.mean(xf * xf, axis=-1, keepdims=True) + EPS)
    return (y * g.astype(jnp.float32)).astype(x.dtype)


def split_columns(h):
    outs, start = [], 0
    for size in COL_SIZES:
        outs.append(h[..., start:start + size])
        start += size
    return outs


def to_heads(t, n_heads):
    b, s, w = t.shape
    return t.reshape(b, s, n_heads, w // n_heads).transpose(0, 2, 1, 3)


def from_heads(t):
    b, h, s, d = t.shape
    return t.transpose(0, 2, 1, 3).reshape(b, s, h * d)


def rope(x, pos):
    d = x.shape[-1]
    inv_freq = ROPE_THETA ** (-jnp.arange(0, d, 2, dtype=jnp.float32) / d)
    ang = pos.astype(jnp.float32)[:, None] * inv_freq[None, :]
    cos, sin = jnp.cos(ang), jnp.sin(ang)
    xf = x.astype(jnp.float32)
    x1, x2 = xf[..., : d // 2], xf[..., d // 2:]
    out = jnp.concatenate([x1 * cos - x2 * sin, x2 * cos + x1 * sin], axis=-1)
    return out.astype(x.dtype)


def blocks_to_seq(o):
    nb, b, h, qb, d = o.shape
    return o.transpose(1, 2, 0, 3, 4).reshape(b, h, nb * qb, d)


def forgetting_attention(q, k, v, log_f):
    seq = q.shape[2]
    scale = HEAD_DIM ** -0.5
    cum_f = jnp.cumsum(log_f, axis=-1)
    kpos = jnp.arange(seq)

    def one_block(i):
        start = i * Q_BLOCK
        qb = lax.dynamic_slice_in_dim(q, start, Q_BLOCK, axis=2)
        fq = lax.dynamic_slice_in_dim(cum_f, start, Q_BLOCK, axis=2)
        s = jnp.einsum('bhqd,bhkd->bhqk', qb, k, preferred_element_type=jnp.float32) * scale
        s = s + (fq[..., :, None] - cum_f[..., None, :])
        qpos = start + jnp.arange(Q_BLOCK)
        mask = kpos[None, :] <= qpos[:, None]
        s = jnp.where(mask, s, -jnp.inf)
        p = jax.nn.softmax(s, axis=-1)
        return jnp.einsum('bhqk,bhkd->bhqd', p.astype(v.dtype), v)

    out = lax.map(one_block, jnp.arange(seq // Q_BLOCK))
    return blocks_to_seq(out)


def differential_attention(q, k, v, lam, subln_g, lambda_init):
    b, h2, seq, _ = q.shape
    scale = HEAD_DIM ** -0.5
    kchunk = jnp.arange(seq) // CHUNK

    def one_block(i):
        start = i * Q_BLOCK
        qb = lax.dynamic_slice_in_dim(q, start, Q_BLOCK, axis=2)
        s = jnp.einsum('bhqd,bhkd->bhqk', qb, k, preferred_element_type=jnp.float32) * scale
        qchunk = (start + jnp.arange(Q_BLOCK)) // CHUNK
        mask = kchunk[None, :] <= qchunk[:, None]
        s = jnp.where(mask, s, -jnp.inf)
        p = jax.nn.softmax(s, axis=-1).reshape(b, h2 // 2, 2, Q_BLOCK, seq)
        a = p[:, :, 0] - lam * p[:, :, 1]
        return jnp.einsum('bhqk,bhkd->bhqd', a.astype(v.dtype), v)

    out = blocks_to_seq(lax.map(one_block, jnp.arange(seq // Q_BLOCK)))
    out = rms_norm(out, subln_g)
    return (out.astype(jnp.float32) * (1.0 - lambda_init)).astype(v.dtype)


def setup_inputs(seed: int = 0) -> dict:
    key = jax.random.key(seed)
    ks = jax.random.split(key, 12)
    x = jax.random.normal(ks[0], (BATCH, SEQ, D_MODEL), jnp.float32)
    norm_g = 1.0 + 0.02 * jax.random.normal(ks[1], (DEPTH, D_MODEL), jnp.float32)
    w_in = jax.random.normal(ks[2], (DEPTH, D_MODEL, IN_COLS), jnp.float32) * D_MODEL ** -0.5
    b_forget = FORGET_BIAS_OFFSET + 0.5 * jax.random.normal(ks[3], (DEPTH, N_HEADS_FOX), jnp.float32)
    lambda_q1 = 0.1 * jax.random.normal(ks[4], (DEPTH, HEAD_DIM), jnp.float32)
    lambda_k1 = 0.1 * jax.random.normal(ks[5], (DEPTH, HEAD_DIM), jnp.float32)
    lambda_q2 = 0.1 * jax.random.normal(ks[6], (DEPTH, HEAD_DIM), jnp.float32)
    lambda_k2 = 0.1 * jax.random.normal(ks[7], (DEPTH, HEAD_DIM), jnp.float32)
    subln_g = 1.0 + 0.02 * jax.random.normal(ks[8], (DEPTH, DIFF_V_DIM), jnp.float32)
    w_out = jax.random.normal(ks[9], (DEPTH, MIX_WIDTH, D_MODEL), jnp.float32) * MIX_WIDTH ** -0.5
    final_g = 1.0 + 0.02 * jax.random.normal(ks[10], (D_MODEL,), jnp.float32)
    return {"x": x, "norm_g": norm_g, "w_in": w_in, "b_forget": b_forget,
            "lambda_q1": lambda_q1, "lambda_k1": lambda_k1,
            "lambda_q2": lambda_q2, "lambda_k2": lambda_k2,
            "subln_g": subln_g, "w_out": w_out, "final_g": final_g}


def reference(x, norm_g, w_in, b_forget, lambda_q1, lambda_k1, lambda_q2, lambda_k2,
              subln_g, w_out, final_g):
    seq = x.shape[1]
    pos = jnp.arange(seq, dtype=jnp.int32)
    h = x
    for layer in range(DEPTH):
        lambda_init = 0.8 - 0.6 * math.exp(-0.3 * layer)
        u = rms_norm(h, norm_g[layer])
        proj = jnp.einsum('bsd,dc->bsc', u, w_in[layer])
        (fq, fk, fv, fg, fz, dq, dk, dv, dg) = split_columns(proj)

        z = fz.astype(jnp.float32) + b_forget[layer].astype(jnp.float32)
        log_f = jax.nn.log_sigmoid(z).transpose(0, 2, 1)
        y_fox = forgetting_attention(to_heads(fq, N_HEADS_FOX), to_heads(fk, N_HEADS_FOX),
                                     to_heads(fv, N_HEADS_FOX), log_f)
        y_fox = from_heads(y_fox) * jax.nn.silu(fg)

        lam = (jnp.exp(jnp.sum(lambda_q1[layer].astype(jnp.float32) * lambda_k1[layer].astype(jnp.float32)))
               - jnp.exp(jnp.sum(lambda_q2[layer].astype(jnp.float32) * lambda_k2[layer].astype(jnp.float32)))
               + lambda_init)
        qd = rope(to_heads(dq, 2 * N_HEADS_DIFF), pos)
        kd = rope(to_heads(dk, 2 * N_HEADS_DIFF), pos)
        vd = to_heads(dv, N_HEADS_DIFF)
        y_diff = differential_attention(qd, kd, vd, lam, subln_g[layer], lambda_init)
        y_diff = from_heads(y_diff) * jax.nn.silu(dg)

        mixed = jnp.concatenate([y_fox, y_diff], axis=-1)
        h = h + jnp.einsum('bsc,cd->bsd', mixed, w_out[layer])
    return rms_norm(h, final_g)
```

```cpp
#include <hip/hip_runtime.h>
#include <hip/hip_cooperative_groups.h>
#include <cstdio>
#include <cstdint>
namespace cg = cooperative_groups;
#ifndef MK_N_LAUNCHES
#define MK_N_LAUNCHES 1
#endif
constexpr int SEQ = 16384, DM = 1024, NCOL_IN = 4104, NPROJ = 4096;
constexpr float LOG2E = 1.4426950408889634f;
constexpr float C2F = 0.125f * 1.4426950408889634f;
constexpr float EPS = 1e-6f;
namespace pg8 {
#define PG8_LAS __attribute__((address_space(3)))
typedef unsigned short bf16_t;
typedef short bf16x8 __attribute__((ext_vector_type(8)));
typedef float f32x4 __attribute__((ext_vector_type(4)));
typedef unsigned u32x4 __attribute__((ext_vector_type(4)));
constexpr int BM = 256, BK = 64, HALF = 128, HTB = HALF * BK * 2  , STAGE_BYTES = 8 * HTB, NXCD = 8, WGM = 8;

__host__ __device__ __forceinline__ int lds_byte(int r, int c) { const int st = (r >> 4) * 2 + (c >> 5), rr = r & 15, cc = c & 31, ob = rr * 64 + cc * 2; return st * 1024 + (ob ^ (((ob >> 9) & 1) << 5)); }
__host__ __device__ __forceinline__ void stage_rc(int b, int& R, int& C) { const int st = b / 1024, sb = b % 1024, swz = sb ^ (((sb >> 9) & 1) << 5); R = (st >> 1) * 16 + swz / 64; C = (st & 1) * 32 + (swz % 64) / 2; }
__host__ __device__ __forceinline__ int perm32(int rho) { const int n = rho >> 4, i = rho & 15; return 8 * (i >> 2) + 4 * n + (i & 3); }

struct Unit { int pm, pn; };
struct Gemm { const bf16_t* A; const bf16_t* Bt; int M, N, K; };

struct StaticOrder {
    int nM, nN, nwg, G, c;
    __host__ __device__ void init(int M, int N, int G_, int c_) { nM = M / BM; nN = N / BM; nwg = nM * nN; G = G_; c = c_; }
    __host__ __device__ bool next(int i, Unit& u) const {
        const long L = (long)i * G + c; if (L >= nwg) return false;
        int wgid = (int)L; { const int q = nwg / NXCD, r = nwg % NXCD, xcd = wgid % NXCD, off = wgid / NXCD; wgid = (xcd < r ? xcd * (q + 1) : r * (q + 1) + (xcd - r) * q) + off; }
        const int nig = WGM * nN, gid = wgid / nig, fm = gid * WGM, gsz = (nM - fm) < WGM ? (nM - fm) : WGM;
        u.pm = fm + ((wgid % nig) % gsz); u.pn = (wgid % nig) / gsz; return true;
    }
    __device__ __forceinline__ void a_ready(const Unit&) const {}
    __device__ __forceinline__ void done(const Unit&) const {}
};


typedef float f32x2 __attribute__((ext_vector_type(2)));
typedef __bf16 bf16x2_t __attribute__((ext_vector_type(2)));
__device__ __forceinline__ unsigned cvt_pk_bf16(float lo, float hi) { f32x2 v = {lo, hi}; bf16x2_t b = __builtin_convertvector(v, bf16x2_t); return __builtin_bit_cast(unsigned, b); }
__device__ __forceinline__ float silu_f(float v) { return v * __builtin_amdgcn_rcpf(1.0f + __builtin_amdgcn_exp2f(-LOG2E * v)); }

struct EpiProj {
    static constexpr bool PERM = true, AFTER_DRAIN = false;
    bf16_t* P; const float* rope;
    template <int MODE  >
    __device__ __forceinline__ void run(const f32x4 (&acc)[2][2][4][2], const Unit& u, int wr, int wc, int fr, int fq) const {
        const int row0 = u.pm * BM + wr * 64 + fr, within = 32 * (wc & 1) + 8 * fq, slot0 = 4 * u.pn + (wc >> 1);
#pragma unroll
        for (int ai = 0; ai < 2; ++ai)
#pragma unroll
            for (int m = 0; m < 4; ++m) {
                const int row = row0 + ai * HALF + m * 16;
                f32x4 c01 = {1.f, 0.f, 1.f, 0.f}, c23 = {1.f, 0.f, 1.f, 0.f};
                if (MODE >= 3) { const f32x4* rp = (const f32x4*)(rope + ((size_t)row * 32 + 16 * (wc & 1) + 4 * fq) * 2); c01 = rp[0]; c23 = rp[1]; }
#pragma unroll
                for (int bj = 0; bj < 2; ++bj) {
                    f32x4 v0 = acc[ai][bj][m][0], v1 = acc[ai][bj][m][1];
                    if (MODE >= 3) {
                        f32x4 r0, r1;
                        r0[0] = v0[0] * c01[0] - v0[1] * c01[1]; r0[1] = v0[1] * c01[0] + v0[0] * c01[1];
                        r0[2] = v0[2] * c01[2] - v0[3] * c01[3]; r0[3] = v0[3] * c01[2] + v0[2] * c01[3];
                        r1[0] = v1[0] * c23[0] - v1[1] * c23[1]; r1[1] = v1[1] * c23[0] + v1[0] * c23[1];
                        r1[2] = v1[2] * c23[2] - v1[3] * c23[3]; r1[3] = v1[3] * c23[2] + v1[2] * c23[3];
                        v0 = r0; v1 = r1;
                    }
                    if (MODE == 1 || MODE == 4) { v0 = v0 * C2F; v1 = v1 * C2F; }
                    if (MODE == 2) { v0[0] = silu_f(v0[0]); v0[1] = silu_f(v0[1]); v0[2] = silu_f(v0[2]); v0[3] = silu_f(v0[3]);
                                     v1[0] = silu_f(v1[0]); v1[1] = silu_f(v1[1]); v1[2] = silu_f(v1[2]); v1[3] = silu_f(v1[3]); }
                    u32x4 w; w.x = cvt_pk_bf16(v0[0], v0[1]); w.y = cvt_pk_bf16(v0[2], v0[3]); w.z = cvt_pk_bf16(v1[0], v1[1]); w.w = cvt_pk_bf16(v1[2], v1[3]);
                    *(u32x4*)(P + ((size_t)(slot0 + 2 * bj) * SEQ + row) * 64 + within) = w;
                }
            }
    }
    __device__ __forceinline__ void operator()(const f32x4 (&acc)[2][2][4][2], const Unit& u, int wr, int wc, int fr, int fq) const {
        const int g = u.pn >> 1;
        if (g == 0) run<1>(acc, u, wr, wc, fr, fq);
        else if (g == 3 || g == 7) run<2>(acc, u, wr, wc, fr, fq);
        else if (g == 4) run<4>(acc, u, wr, wc, fr, fq);
        else if (g == 5) run<3>(acc, u, wr, wc, fr, fq);
        else run<0>(acc, u, wr, wc, fr, fq);
    }
};

struct EpiOut {
    static constexpr bool PERM = false, AFTER_DRAIN = false;
    const float* x; float* out; float* rowss;
    __device__ __forceinline__ void operator()(const f32x4 (&acc)[2][2][4][2], const Unit& u, int wr, int wc, int fr, int fq) const {
        const int col0 = u.pn * BM + wc * 32 + 4 * fq;
#pragma unroll
        for (int ai = 0; ai < 2; ++ai)
#pragma unroll
            for (int m = 0; m < 4; ++m) {
                const int row = u.pm * BM + ai * HALF + wr * 64 + m * 16 + fr; const size_t off = (size_t)row * DM + col0; float ss = 0.f;
#pragma unroll
                for (int bj = 0; bj < 2; ++bj)
#pragma unroll
                    for (int n = 0; n < 2; ++n) { const f32x4 xv = *(const f32x4*)(x + off + bj * HALF + n * 16); const f32x4 h = xv + acc[ai][bj][m][n];
                        *(f32x4*)(out + off + bj * HALF + n * 16) = h; ss += (h[0] * h[0] + h[1] * h[1]) + (h[2] * h[2] + h[3] * h[3]); }
                ss += __shfl_xor(ss, 16); ss += __shfl_xor(ss, 32);
                if (fq == 0) unsafeAtomicAdd(rowss + row, ss);
            }
    }
};

template <class Epi, class Sched, bool ALIGN_EPI = false, bool SP2 = false>
__device__ __forceinline__ void gemm_phase(PG8_LAS unsigned char* lds, const Gemm g, const Sched& S, const Epi& E) {
    const int tid = threadIdx.x, wid = __builtin_amdgcn_readfirstlane(tid >> 6), lane = tid & 63, wr = wid >> 2, wc = wid & 3, fr = lane & 15, fq = lane >> 4;
    const int K = g.K, nt = K / BK;
    unsigned voffA[2], voffB[2];
#pragma unroll
    for (int i = 0; i < 2; ++i) { int R, C; stage_rc(tid * 16 + i * 8192, R, C); const int Rb = Epi::PERM ? ((R & ~31) + perm32(R & 31)) : R;
        voffA[i] = (unsigned)(R * K + C) * 2u; voffB[i] = (unsigned)(Rb * K + C) * 2u; }
    const size_t kstep = (size_t)(BK * 2);
    const size_t hstep = (size_t)HALF * K * 2;
    const size_t tstep = 2 * hstep;
    const unsigned ldsw = (unsigned)wid * 1024u;
    const int aoff = lds_byte(wr * 64 + fr, fq * 8), boff = lds_byte(wc * 32 + fr, fq * 8);
#define PG8_SA(b, h) (((b) * 2 + (h)) * HTB)
#define PG8_SB(b, h) ((4 + (b) * 2 + (h)) * HTB)
#define PG8_STAGE(bufoff, gbase, voff) do { _Pragma("unroll") for (int _i = 0; _i < 2; ++_i) \
        __builtin_amdgcn_global_load_lds((const unsigned*)((const char*)(gbase) + (voff)[_i]), (PG8_LAS unsigned*)(lds + (bufoff) + ldsw + _i * 8192), 16, 0, 0); } while (0)
#define PG8_LDA(dst, b, h) do { _Pragma("unroll") for (int m = 0; m < 4; ++m) _Pragma("unroll") for (int k = 0; k < 2; ++k) dst[m][k] = *(const PG8_LAS bf16x8*)(lds + PG8_SA(b, h) + aoff + m * 2048 + k * 1024); } while (0)
#define PG8_LDB(dst, b, h) do { _Pragma("unroll") for (int n = 0; n < 2; ++n) _Pragma("unroll") for (int k = 0; k < 2; ++k) dst[n][k] = *(const PG8_LAS bf16x8*)(lds + PG8_SB(b, h) + boff + n * 2048 + k * 1024); } while (0)
#define PG8_MMA(ai, bj, At, Bt) do { __builtin_amdgcn_s_setprio(1); _Pragma("unroll") for (int m = 0; m < 4; ++m) _Pragma("unroll") for (int n = 0; n < 2; ++n) _Pragma("unroll") for (int k = 0; k < 2; ++k) \
        acc[ai][bj][m][n] = __builtin_amdgcn_mfma_f32_16x16x32_bf16(Bt[n][k], At[m][k], acc[ai][bj][m][n], 0, 0, 0); __builtin_amdgcn_s_setprio(0); } while (0)
#define PG8_WAIT_V(n) asm volatile("s_waitcnt vmcnt(" #n ")" ::: "memory")
#define PG8_WAIT_L(n) asm volatile("s_waitcnt lgkmcnt(" #n ")" ::: "memory")
#define PG8_BAR __builtin_amdgcn_s_barrier()
#define PG8_SCHED __builtin_amdgcn_sched_barrier(0)
    Unit cur, nxt; int ui = 0;
    if (!S.next(0, cur)) return;
    f32x4 acc[2][2][4][2];
#pragma unroll
    for (int a = 0; a < 2; ++a)
#pragma unroll
        for (int b = 0; b < 2; ++b)
#pragma unroll
            for (int m = 0; m < 4; ++m)
#pragma unroll
                for (int n = 0; n < 2; ++n) acc[a][b][m][n] = (f32x4){0.f, 0.f, 0.f, 0.f};
    bf16x8 At[4][2], B0[2][2], B1[2][2];
    const char* cA = (const char*)g.A + (size_t)cur.pm * tstep; const char* cB = (const char*)g.Bt + (size_t)cur.pn * tstep;
    S.a_ready(cur);
    if constexpr (SP2) {
        PG8_STAGE(PG8_SB(0, 0), cB, voffB); PG8_STAGE(PG8_SB(0, 1), cB + hstep, voffB); PG8_STAGE(PG8_SA(0, 0), cA, voffA); PG8_STAGE(PG8_SA(0, 1), cA + hstep, voffA);
        if (wr == 1) PG8_BAR;
        PG8_WAIT_V(2); PG8_BAR;
        PG8_STAGE(PG8_SB(1, 0), cB + kstep, voffB); PG8_STAGE(PG8_SA(1, 0), cA + kstep, voffA); PG8_STAGE(PG8_SB(1, 1), cB + hstep + kstep, voffB);
        PG8_WAIT_V(6); PG8_BAR;
    } else {
        PG8_STAGE(PG8_SB(0, 0), cB, voffB); PG8_STAGE(PG8_SA(0, 0), cA, voffA); PG8_STAGE(PG8_SB(0, 1), cB + hstep, voffB); PG8_STAGE(PG8_SA(0, 1), cA + hstep, voffA);
        if (wr == 1) PG8_BAR;
        PG8_WAIT_V(4); PG8_BAR;
        PG8_STAGE(PG8_SB(1, 0), cB + kstep, voffB); PG8_STAGE(PG8_SA(1, 0), cA + kstep, voffA); PG8_STAGE(PG8_SB(1, 1), cB + hstep + kstep, voffB);
        PG8_WAIT_V(6); PG8_BAR;
    }
    for (;;) {
        const bool has_next = S.next(ui + 1, nxt);
        const char* nA = has_next ? (const char*)g.A + (size_t)nxt.pm * tstep : cA; const char* nB = has_next ? (const char*)g.Bt + (size_t)nxt.pn * tstep : cB;
        for (int t = 0; t < nt; t += 2) {
            const bool last = (t == nt - 2);
            const char* a1 = cA + (size_t)(t + 1) * kstep;
            const char* a2 = last ? nA : cA + (size_t)(t + 2) * kstep; const char* b2 = last ? nB : cB + (size_t)(t + 2) * kstep;
            const char* a3 = a2 + kstep; const char* b3 = b2 + kstep;
            if (last && has_next) S.a_ready(nxt);
            if constexpr (SP2) {
            PG8_LDB(B0, 0, 0); PG8_LDB(B1, 0, 1); PG8_SCHED; PG8_LDA(At, 0, 0); PG8_STAGE(PG8_SA(1, 1), a1 + hstep, voffA);
            PG8_WAIT_V(8); PG8_WAIT_L(0); PG8_BAR; PG8_MMA(0, 0, At, B0); PG8_MMA(0, 1, At, B1); PG8_BAR; PG8_SCHED;
            PG8_LDA(At, 0, 1); PG8_STAGE(PG8_SB(0, 0), b2, voffB); PG8_STAGE(PG8_SB(0, 1), b2 + hstep, voffB); PG8_STAGE(PG8_SA(0, 0), a2, voffA);
            PG8_WAIT_V(8); PG8_WAIT_L(0); PG8_BAR; PG8_MMA(1, 0, At, B0); PG8_MMA(1, 1, At, B1); PG8_BAR; PG8_SCHED;
            PG8_LDB(B0, 1, 0); PG8_LDB(B1, 1, 1); PG8_SCHED; PG8_LDA(At, 1, 0); PG8_STAGE(PG8_SA(0, 1), a2 + hstep, voffA);
            PG8_WAIT_V(8); PG8_WAIT_L(0); PG8_BAR; PG8_MMA(0, 0, At, B0); PG8_MMA(0, 1, At, B1); PG8_BAR; PG8_SCHED;
            PG8_LDA(At, 1, 1); PG8_STAGE(PG8_SB(1, 0), b3, voffB); PG8_STAGE(PG8_SB(1, 1), b3 + hstep, voffB); PG8_STAGE(PG8_SA(1, 0), a3, voffA);
            PG8_WAIT_V(8); PG8_WAIT_L(0); PG8_BAR; PG8_MMA(1, 0, At, B0); PG8_MMA(1, 1, At, B1); PG8_BAR; PG8_SCHED;
            } else {
            PG8_LDB(B0, 0, 0); PG8_SCHED; PG8_LDA(At, 0, 0); PG8_STAGE(PG8_SA(1, 1), a1 + hstep, voffA);
            PG8_WAIT_L(8); PG8_BAR; PG8_WAIT_L(0); PG8_MMA(0, 0, At, B0); PG8_BAR; PG8_SCHED;
            PG8_LDB(B1, 0, 1); PG8_STAGE(PG8_SB(0, 0), b2, voffB);
            PG8_BAR; PG8_WAIT_L(0); PG8_MMA(0, 1, At, B1); PG8_BAR;
            PG8_LDA(At, 0, 1); PG8_STAGE(PG8_SA(0, 0), a2, voffA);
            PG8_BAR; PG8_WAIT_L(0); PG8_MMA(1, 0, At, B0); PG8_BAR; PG8_SCHED;
            PG8_STAGE(PG8_SB(0, 1), b2 + hstep, voffB);
            PG8_WAIT_V(6); PG8_BAR; PG8_MMA(1, 1, At, B1); PG8_BAR;
            PG8_LDB(B0, 1, 0); PG8_SCHED; PG8_LDA(At, 1, 0); PG8_STAGE(PG8_SA(0, 1), a2 + hstep, voffA);
            PG8_WAIT_L(8); PG8_BAR; PG8_WAIT_L(0); PG8_MMA(0, 0, At, B0); PG8_BAR; PG8_SCHED;
            PG8_LDB(B1, 1, 1); PG8_STAGE(PG8_SB(1, 0), b3, voffB);
            PG8_BAR; PG8_WAIT_L(0); PG8_MMA(0, 1, At, B1); PG8_BAR;
            PG8_LDA(At, 1, 1); PG8_STAGE(PG8_SA(1, 0), a3, voffA);
            PG8_BAR; PG8_WAIT_L(0); PG8_MMA(1, 0, At, B0); PG8_BAR; PG8_SCHED;
            PG8_STAGE(PG8_SB(1, 1), b3 + hstep, voffB);
            PG8_WAIT_V(6); PG8_BAR; PG8_MMA(1, 1, At, B1); PG8_BAR;
            }
        }
        if constexpr (ALIGN_EPI) { if (wr == 0) PG8_BAR; }
        if constexpr (!Epi::AFTER_DRAIN) { E(acc, cur, wr, wc, fr, fq); S.done(cur); }
        if (!has_next) break;
#pragma unroll
        for (int a = 0; a < 2; ++a)
#pragma unroll
            for (int b = 0; b < 2; ++b)
#pragma unroll
                for (int m = 0; m < 4; ++m)
#pragma unroll
                    for (int n = 0; n < 2; ++n) acc[a][b][m][n] = (f32x4){0.f, 0.f, 0.f, 0.f};
        cur = nxt; cA = nA; cB = nB; ++ui;
        if constexpr (ALIGN_EPI) { if (wr == 1) PG8_BAR; }
    }
    PG8_WAIT_V(0);
    if constexpr (!ALIGN_EPI) { if (wr == 0) PG8_BAR; }
    PG8_BAR;
    if constexpr (Epi::AFTER_DRAIN) { E.fused(acc, cur, wr, wc, fr, fq, lds, wid, lane); S.done(cur); }
#undef PG8_SA
#undef PG8_SB
#undef PG8_STAGE
#undef PG8_LDA
#undef PG8_LDB
#undef PG8_MMA
#undef PG8_WAIT_V
#undef PG8_WAIT_L
#undef PG8_BAR
#undef PG8_SCHED
}
}

namespace att {
#define LAS __attribute__((address_space(3)))
typedef unsigned short bf16_t;
typedef short bf16x8 __attribute__((ext_vector_type(8)));
typedef short s16x4 __attribute__((ext_vector_type(4)));
typedef short v4i16_t __attribute__((ext_vector_type(4)));
typedef float f32x16 __attribute__((ext_vector_type(16)));
typedef float f32x4 __attribute__((ext_vector_type(4)));
typedef float f32x2 __attribute__((ext_vector_type(2)));
typedef unsigned u32x4 __attribute__((ext_vector_type(4)));
typedef __bf16 bf16x2_t __attribute__((ext_vector_type(2)));
constexpr int K_OFF = 0, V_OFF = 16384, G_OFF = 49152, FLAG_OFF = 49664, WSF_OFF = 50176, OST_OFF = 53248, ATT_BYTES = OST_OFF + 8 * 8192;
constexpr float THR = 8.0f;
__device__ __forceinline__ int crow(int r, int hi) { return (r & 3) + 8 * (r >> 2) + 4 * hi; }
__device__ __forceinline__ unsigned cvtpk(float lo, float hi) { f32x2 v = {lo, hi}; bf16x2_t b = __builtin_convertvector(v, bf16x2_t); return __builtin_bit_cast(unsigned, b); }
__device__ __forceinline__ void glds16(const void* g, unsigned lds_dst) { unsigned keep;
    asm volatile("s_mov_b32 %0, m0\n\ts_mov_b32 m0, %2\n\ts_nop 0\n\tglobal_load_lds_dwordx4 %1, off\n\ts_mov_b32 m0, %0" : "=&s"(keep) : "v"(g), "s"(lds_dst) : "memory"); }
__device__ __forceinline__ void glds4(const void* g, unsigned lds_dst) { unsigned keep;
    asm volatile("s_mov_b32 %0, m0\n\ts_mov_b32 m0, %2\n\ts_nop 0\n\tglobal_load_lds_dword %1, off\n\ts_mov_b32 m0, %0" : "=&s"(keep) : "v"(g), "s"(lds_dst) : "memory"); }
#define ATT_WAIT_BAR0() asm volatile("s_waitcnt vmcnt(0) lgkmcnt(0)\n\ts_barrier" ::: "memory")
#define ATT_MFMA(a, b, c) __builtin_amdgcn_mfma_f32_32x32x16_bf16(a, b, c, 0, 0, 0)
__device__ __forceinline__ s16x4 vtr(LAS const unsigned char* p) { return __builtin_bit_cast(s16x4, __builtin_amdgcn_ds_read_tr16_b64_v4i16((LAS v4i16_t*)p)); }
__device__ __forceinline__ float rowmax32(const f32x16& p0, const f32x16& p1) {
    float a = __builtin_fmaxf(p0[0], p1[0]);
#pragma unroll
    for (int r = 1; r < 16; ++r) a = __builtin_fmaxf(__builtin_fmaxf(a, p0[r]), p1[r]);
    auto rr = __builtin_amdgcn_permlane32_swap(__float_as_uint(a), __float_as_uint(a), false, false);
    return __builtin_fmaxf(__uint_as_float(rr[0]), __uint_as_float(rr[1]));
}
__device__ __forceinline__ float halfsum(float v) {
    auto rr = __builtin_amdgcn_permlane32_swap(__float_as_uint(v), __float_as_uint(v), false, false);
    return __uint_as_float(rr[0]) + __uint_as_float(rr[1]);
}

template <int DV, bool FOX>
__device__ __forceinline__ void attn_pass(LAS unsigned char* lds, const bf16_t* __restrict__ Qh, const bf16_t* __restrict__ Kh, const bf16_t* __restrict__ Va, const bf16_t* __restrict__ Vb,
                                          const float* __restrict__ Gh, int qb, f32x16 (&o)[DV / 32], float& l_out) {
    const int tid = threadIdx.x, lane = tid & 63, r32 = lane & 31, hi = lane >> 5;
    const int w = __builtin_amdgcn_readfirstlane(tid >> 6);
    const int q0 = qb * 256, NTu = 4 * qb + 4, my_nt = 4 * qb + (w >> 1) + 1;
    const unsigned lds0 = (unsigned)(uintptr_t)lds;
    LAS float* wsf = (LAS float*)(lds + WSF_OFF) + w * 64;
    const bf16_t* ksrc = Kh + (size_t)lane * 64 + w * 8;
    const size_t voff = (size_t)(16 * (w & 3) + (lane >> 2)) * 64 + (w >> 2) * 32 + (lane & 3) * 8;
    const bf16_t* vsrcA = Va + voff; const bf16_t* vsrcB = (DV == 128) ? Vb + voff : Va;
    const unsigned kdst = lds0 + K_OFF + w * 1024, vdstA = lds0 + V_OFF + w * 1024, vdstB = lds0 + V_OFF + (w + 8) * 1024, gdst = lds0 + G_OFF;
#define ATT_DMA(t, sl) do { const size_t to_ = (size_t)(t) * 4096; \
        glds16(ksrc + to_, (unsigned)__builtin_amdgcn_readfirstlane(kdst + (sl) * 8192)); \
        glds16(vsrcA + to_, (unsigned)__builtin_amdgcn_readfirstlane(vdstA + (sl) * 16384)); \
        if (DV == 128) glds16(vsrcB + to_, (unsigned)__builtin_amdgcn_readfirstlane(vdstB + (sl) * 16384)); \
        if (FOX) { if (w == 0) glds4(Gh + (size_t)(t) * 64 + lane, (unsigned)__builtin_amdgcn_readfirstlane(gdst + (sl) * 256)); } } while (0)
    ATT_DMA(FOX ? NTu - 1 : 0, 0);
    bf16x8 qr[4];
    { const bf16_t* Qw = Qh + (size_t)(q0 + 32 * w + r32) * 64 + hi * 8;
#pragma unroll
      for (int d0 = 0; d0 < 4; ++d0) qr[d0] = *(const bf16x8*)(Qw + d0 * 16); }
    const float gq = FOX ? Gh[q0 + 32 * w + r32] : 0.f;
    f32x16 cinit;
#pragma unroll
    for (int r = 0; r < 16; ++r) cinit[r] = gq;
    float l = 0.f;
#pragma unroll
    for (int d = 0; d < DV / 32; ++d)
#pragma unroll
        for (int r = 0; r < 16; ++r) o[d][r] = 0.f;
    bool first = true;
    for (int i = 0; i < NTu; ++i) {
        ATT_WAIT_BAR0();
        const int t = FOX ? NTu - 1 - i : i, sl = i & 1;
        if (i + 1 < NTu) ATT_DMA(FOX ? t - 1 : t + 1, sl ^ 1);
        if (t < my_nt) {
            LAS const unsigned char* kp = lds + K_OFF + sl * 8192 + hi * 1024 + r32 * 16;
            f32x16 p0, p1;
#pragma unroll
            for (int d0 = 0; d0 < 4; ++d0) {
                const bf16x8 b0 = *(LAS const bf16x8*)(kp + d0 * 2048), b1 = *(LAS const bf16x8*)(kp + d0 * 2048 + 512);
                if (d0 == 0) { p0 = ATT_MFMA(b0, qr[0], cinit); p1 = ATT_MFMA(b1, qr[0], cinit); }
                else { p0 = ATT_MFMA(b0, qr[d0], p0); p1 = ATT_MFMA(b1, qr[d0], p1); }
            }
            if (FOX) {
                LAS const float* gp = (LAS const float*)(lds + G_OFF + sl * 256) + 4 * hi;
#pragma unroll
                for (int g = 0; g < 4; ++g) { const f32x4 a = *(LAS const f32x4*)(gp + 8 * g), b = *(LAS const f32x4*)(gp + 32 + 8 * g);
#pragma unroll
                    for (int e = 0; e < 4; ++e) { p0[4 * g + e] -= a[e]; p1[4 * g + e] -= b[e]; } }
                if (t == my_nt - 1) {
                    const int lim = 32 * (w & 1) + r32;
#pragma unroll
                    for (int r = 0; r < 16; ++r) { const int kk = crow(r, hi); if (kk > lim) p0[r] = -INFINITY; if (kk + 32 > lim) p1[r] = -INFINITY; }
                }
            }
            const float rm = rowmax32(p0, p1);
            if (first || __any(rm > THR)) {
                const float dl = first ? rm : __builtin_fmaxf(rm, 0.f);
                p0 = p0 - dl; p1 = p1 - dl; cinit = cinit - dl;
                if (!first) {
                    const float f = __builtin_amdgcn_exp2f(-dl); l *= f;
                    if (hi == 0) wsf[r32] = f;
                    __builtin_amdgcn_fence(__ATOMIC_RELEASE, "wavefront");
#pragma unroll
                    for (int r = 0; r < 16; ++r) { const float fr_ = wsf[crow(r, hi)];
#pragma unroll
                        for (int d = 0; d < DV / 32; ++d) o[d][r] *= fr_; }
                }
                first = false;
            }
            float sacc = 0.f;
#pragma unroll
            for (int r = 0; r < 16; ++r) { p0[r] = __builtin_amdgcn_exp2f(p0[r]); p1[r] = __builtin_amdgcn_exp2f(p1[r]); sacc += p0[r] + p1[r]; }
            l += sacc;
            u32x4 pw[4];
#pragma unroll
            for (int s = 0; s < 2; ++s) {
                pw[s]     = (u32x4){cvtpk(p0[8 * s], p0[8 * s + 1]), cvtpk(p0[8 * s + 2], p0[8 * s + 3]), cvtpk(p0[8 * s + 4], p0[8 * s + 5]), cvtpk(p0[8 * s + 6], p0[8 * s + 7])};
                pw[2 + s] = (u32x4){cvtpk(p1[8 * s], p1[8 * s + 1]), cvtpk(p1[8 * s + 2], p1[8 * s + 3]), cvtpk(p1[8 * s + 4], p1[8 * s + 5]), cvtpk(p1[8 * s + 6], p1[8 * s + 7])};
            }
            LAS const unsigned char* vp = lds + V_OFF + sl * 16384 + ((lane >> 4) & 1) * 32 + (lane & 3) * 8 + (4 * hi + ((lane & 15) >> 2)) * 64;
#pragma unroll
            for (int d = 0; d < DV / 32; ++d)
#pragma unroll
                for (int s = 0; s < 4; ++s) {
                    const s16x4 lo = vtr(vp + d * 4096 + s * 1024), hh = vtr(vp + d * 4096 + s * 1024 + 512);
                    const bf16x8 vf = (bf16x8){lo[0], lo[1], lo[2], lo[3], hh[0], hh[1], hh[2], hh[3]};
                    o[d] = ATT_MFMA(__builtin_bit_cast(bf16x8, pw[s]), vf, o[d]);
                }
        }
    }
    ATT_WAIT_BAR0();
    l_out = halfsum(l);
#undef ATT_DMA
}

__device__ __forceinline__ void row_recip(LAS float* wsf, float l, int r32, int hi, float (&rli)[16]) {
    if (hi == 0) wsf[32 + r32] = l;
    __builtin_amdgcn_fence(__ATOMIC_RELEASE, "wavefront");
#pragma unroll
    for (int r = 0; r < 16; ++r) rli[r] = __builtin_amdgcn_rcpf(wsf[32 + crow(r, hi)]);
}
__device__ __forceinline__ void stage_gate_store(LAS float* stg, const f32x16& a0, const f32x16& a1, int lane, int r32, int hi,
                                                 const bf16_t* __restrict__ gate  , bf16_t* __restrict__ outp  ) {
#pragma unroll
    for (int r = 0; r < 16; ++r) { const int orow = crow(r, hi); stg[orow * 64 + r32] = a0[r]; stg[orow * 64 + 32 + r32] = a1[r]; }
    __builtin_amdgcn_fence(__ATOMIC_RELEASE, "wavefront");
#pragma unroll
    for (int i = 0; i < 4; ++i) {
        const int row = i * 8 + (lane >> 3), ch = lane & 7;
        const f32x4 x0 = *(LAS const f32x4*)(stg + row * 64 + ch * 8), x1 = *(LAS const f32x4*)(stg + row * 64 + ch * 8 + 4);
        const u32x4 gv = *(const u32x4*)(gate + (size_t)row * 64 + ch * 8);
        u32x4 ov;
        ov.x = cvtpk(x0[0] * __uint_as_float(gv.x << 16), x0[1] * __uint_as_float(gv.x & 0xffff0000u));
        ov.y = cvtpk(x0[2] * __uint_as_float(gv.y << 16), x0[3] * __uint_as_float(gv.y & 0xffff0000u));
        ov.z = cvtpk(x1[0] * __uint_as_float(gv.z << 16), x1[1] * __uint_as_float(gv.z & 0xffff0000u));
        ov.w = cvtpk(x1[2] * __uint_as_float(gv.w << 16), x1[3] * __uint_as_float(gv.w & 0xffff0000u));
        *(u32x4*)(outp + (size_t)row * DM + ch * 8) = ov;
    }
    __builtin_amdgcn_fence(__ATOMIC_RELEASE, "wavefront");
}

__device__ __forceinline__ const bf16_t* slot_ptr(const bf16_t* P, int s) { return P + (size_t)s * SEQ * 64; }

__device__ __forceinline__ void fox_unit(LAS unsigned char* lds, const bf16_t* P, const float* G, bf16_t* MIXED, int h, int qb) {
    const int tid = threadIdx.x, lane = tid & 63, r32 = lane & 31, hi = lane >> 5; const int w = __builtin_amdgcn_readfirstlane(tid >> 6);
    f32x16 o[2]; float l;
    attn_pass<64, true>(lds, slot_ptr(P, h), slot_ptr(P, 8 + h), slot_ptr(P, 16 + h), nullptr, G + (size_t)h * SEQ, qb, o, l);
    LAS float* wsf = (LAS float*)(lds + WSF_OFF) + w * 64; float rli[16];
    row_recip(wsf, l, r32, hi, rli);
#pragma unroll
    for (int r = 0; r < 16; ++r) { o[0][r] *= rli[r]; o[1][r] *= rli[r]; }
    const int row0 = qb * 256 + 32 * w;
    stage_gate_store((LAS float*)(lds + OST_OFF + w * 8192), o[0], o[1], lane, r32, hi, slot_ptr(P, 24 + h) + (size_t)row0 * 64, MIXED + (size_t)row0 * DM + h * 64);
}

__device__ __forceinline__ void diff_unit(LAS unsigned char* lds, const bf16_t* P, bf16_t* MIXED, float* stash, float lam, const float* __restrict__ subln_g, int hd, int qb) {
    const int tid = threadIdx.x, lane = tid & 63, r32 = lane & 31, hi = lane >> 5; const int w = __builtin_amdgcn_readfirstlane(tid >> 6);
    LAS float* wsf = (LAS float*)(lds + WSF_OFF) + w * 64; float rli[16];
    f32x16 o[4]; float l;
    f32x4* st = (f32x4*)(stash + ((size_t)w * 64 + lane) * 64);
    attn_pass<128, false>(lds, slot_ptr(P, 32 + 2 * hd), slot_ptr(P, 40 + 2 * hd), slot_ptr(P, 48 + 2 * hd), slot_ptr(P, 49 + 2 * hd), nullptr, qb, o, l);
    row_recip(wsf, l, r32, hi, rli);
#pragma unroll
    for (int d = 0; d < 4; ++d)
#pragma unroll
        for (int r4 = 0; r4 < 4; ++r4) st[d * 4 + r4] = (f32x4){o[d][4 * r4] * rli[4 * r4], o[d][4 * r4 + 1] * rli[4 * r4 + 1], o[d][4 * r4 + 2] * rli[4 * r4 + 2], o[d][4 * r4 + 3] * rli[4 * r4 + 3]};
    attn_pass<128, false>(lds, slot_ptr(P, 33 + 2 * hd), slot_ptr(P, 41 + 2 * hd), slot_ptr(P, 48 + 2 * hd), slot_ptr(P, 49 + 2 * hd), nullptr, qb, o, l);
    row_recip(wsf, l, r32, hi, rli);
    float ss[16];
#pragma unroll
    for (int r = 0; r < 16; ++r) { rli[r] *= lam; ss[r] = 0.f; }
#pragma unroll
    for (int d = 0; d < 4; ++d) {
#pragma unroll
        for (int r4 = 0; r4 < 4; ++r4) { const f32x4 sv = st[d * 4 + r4];
#pragma unroll
            for (int e = 0; e < 4; ++e) { const int r = 4 * r4 + e; const float v = sv[e] - o[d][r] * rli[r]; o[d][r] = v; ss[r] += v * v; } }
        asm volatile("" ::: "memory");
    }
#pragma unroll
    for (int r = 0; r < 16; ++r) { float s_ = ss[r]; s_ += __shfl_xor(s_, 1); s_ += __shfl_xor(s_, 2); s_ += __shfl_xor(s_, 4); s_ += __shfl_xor(s_, 8); s_ += __shfl_xor(s_, 16);
        ss[r] = __builtin_amdgcn_rsqf(s_ * (1.0f / 128.0f) + EPS) * 0.8f; }
#pragma unroll
    for (int d = 0; d < 4; ++d) { const float gs = subln_g[32 * d + r32];
#pragma unroll
        for (int r = 0; r < 16; ++r) o[d][r] *= ss[r] * gs; }
    const int row0 = qb * 256 + 32 * w;
    LAS float* stg = (LAS float*)(lds + OST_OFF + w * 8192);
    stage_gate_store(stg, o[0], o[1], lane, r32, hi, slot_ptr(P, 56 + 2 * hd) + (size_t)row0 * 64, MIXED + (size_t)row0 * DM + 512 + hd * 128);
    stage_gate_store(stg, o[2], o[3], lane, r32, hi, slot_ptr(P, 57 + 2 * hd) + (size_t)row0 * 64, MIXED + (size_t)row0 * DM + 512 + hd * 128 + 64);
}
#undef LAS
}

#define LAS __attribute__((address_space(3)))
typedef unsigned short bf16;
typedef float f32x4 __attribute__((ext_vector_type(4)));
typedef unsigned v4u __attribute__((ext_vector_type(4)));
constexpr int NWAVES = 8;
constexpr size_t MiB = 1u << 20;
constexpr size_t WS_CTL = 0, CTL_ZERO_BYTES = 1 * MiB;
constexpr size_t WS_WIN = 1 * MiB;
constexpr size_t WS_WOUT = 9 * MiB;
constexpr size_t WS_ROPE = 11 * MiB;
constexpr size_t WS_LOGF = 15 * MiB;
constexpr size_t WS_G = 15 * MiB + 512 * 1024;
constexpr size_t WS_U = 16 * MiB;
constexpr size_t WS_PROJ = 48 * MiB;
constexpr size_t WS_STASH = 176 * MiB;
constexpr size_t WS_END = 208 * MiB;
constexpr int CW_QUEUE = 0;
constexpr size_t CTL_ROWSS = 65536;
constexpr int RING_BYTES = 131072, MISC_OFF = RING_BYTES, LDS_BYTES = 147456;
static_assert(att::ATT_BYTES <= RING_BYTES, "attention LDS map");

__device__ __forceinline__ unsigned f2bf(float f) { unsigned u = __builtin_bit_cast(unsigned, f); return (u + 0x7fffu + ((u >> 16) & 1u)) >> 16; }
__device__ __forceinline__ unsigned pk2(float lo, float hi) { return f2bf(lo) | (f2bf(hi) << 16); }
__device__ __forceinline__ float wave_sum(float v) {
#pragma unroll
    for (int o = 1; o < 64; o <<= 1) v += __shfl_xor(v, o);
    return v;
}
__device__ __forceinline__ int orig_col(int n) {
    const int g = n >> 9, wi = n & 511; const int base = g * 512 + (g >= 4 ? 8 : 0);
    if (g == 4 || g == 5) { const int head = wi >> 6, j = wi & 63; return base + head * 64 + (j >> 1) + 32 * (j & 1); }
    return base + wi;
}
__device__ __forceinline__ void transpose_item(const float* __restrict__ W, int ldw, int K, bf16* __restrict__ WT, LAS float* scr, int item, int nblk, int lane, bool permuted) {
    const int kb = item / nblk, nb = item % nblk, k0 = 64 * kb, n0 = 32 * nb;
    const int col = permuted ? orig_col(n0 + (lane & 31)) : n0 + (lane & 31);
#pragma unroll 8
    for (int i = 0; i < 32; ++i) { const int kk = 2 * i + (lane >> 5); scr[kk * 33 + (lane & 31)] = W[(size_t)(k0 + kk) * ldw + col]; }
    asm volatile("s_waitcnt lgkmcnt(0)" ::: "memory");
    const int c = lane & 7;
#pragma unroll
    for (int j = 0; j < 4; ++j) { const int n = (lane >> 3) + 8 * j; const LAS float* s = scr + (8 * c) * 33 + n;
        v4u o; o.x = pk2(s[0 * 33], s[1 * 33]); o.y = pk2(s[2 * 33], s[3 * 33]); o.z = pk2(s[4 * 33], s[5 * 33]); o.w = pk2(s[6 * 33], s[7 * 33]);
        *(v4u*)(WT + (size_t)(n0 + n) * K + k0 + 8 * c) = o; }
    asm volatile("s_waitcnt lgkmcnt(0)" ::: "memory");
}
__device__ const float ROPE_INVF[32] = {
    1.000000000e+00f, 7.498942018e-01f, 5.623413324e-01f, 4.216965139e-01f, 3.162277639e-01f, 2.371373773e-01f, 1.778279394e-01f, 1.333521456e-01f,
    1.000000015e-01f, 7.498942316e-02f, 5.623413250e-02f, 4.216964915e-02f, 3.162277490e-02f, 2.371373773e-02f, 1.778279431e-02f, 1.333521400e-02f,
    9.999999776e-03f, 7.498942316e-03f, 5.623413250e-03f, 4.216964822e-03f, 3.162277630e-03f, 2.371373819e-03f, 1.778279431e-03f, 1.333521446e-03f,
    1.000000047e-03f, 7.498941850e-04f, 5.623413017e-04f, 4.216965172e-04f, 3.162277571e-04f, 2.371373703e-04f, 1.778279402e-04f, 1.333521504e-04f };
__device__ __forceinline__ void sincos_acc(float ang, float& c, float& s) {
    const double x = (double)ang; const double kq = __builtin_rint(x * 0.63661977236758134308);
    double r = __builtin_fma(-kq, 1.57079632679489655800, x); r = __builtin_fma(-kq, 6.12323399573676603587e-17, r);
    const double r2 = r * r;
    double sp = -1.0 / 1307674368000.0; sp = sp * r2 + 1.0 / 6227020800.0; sp = sp * r2 - 1.0 / 39916800.0; sp = sp * r2 + 1.0 / 362880.0; sp = sp * r2 - 1.0 / 5040.0; sp = sp * r2 + 1.0 / 120.0; sp = sp * r2 - 1.0 / 6.0;
    const double sn = r + r * r2 * sp;
    double cp = 1.0 / 20922789888000.0; cp = cp * r2 - 1.0 / 87178291200.0; cp = cp * r2 + 1.0 / 479001600.0; cp = cp * r2 - 1.0 / 3628800.0; cp = cp * r2 + 1.0 / 40320.0; cp = cp * r2 - 1.0 / 720.0; cp = cp * r2 + 1.0 / 24.0; cp = cp * r2 - 0.5;
    const double cs = 1.0 + r2 * cp;
    const int q = ((int)kq) & 3;
    const double co = (q == 0) ? cs : (q == 1) ? -sn : (q == 2) ? -cs : sn;
    const double so = (q == 0) ? sn : (q == 1) ? cs : (q == 2) ? -sn : -cs;
    c = (float)co; s = (float)so;
}

struct Args { const float* in[11]; float* out; unsigned char* ws; int ph_lo, ph_hi; };

__global__ void __launch_bounds__(NWAVES * 64, 2) hymba_fwd(Args args) {
    extern __shared__ __attribute__((aligned(16))) unsigned char lds_raw[];
    LAS unsigned char* lds = (LAS unsigned char*)lds_raw;
    volatile LAS int* MISC = (volatile LAS int*)(lds + MISC_OFF);
    const int tid = threadIdx.x, lane = tid & 63, wave = __builtin_amdgcn_readfirstlane(tid >> 6);
    const int G = gridDim.x, bx = blockIdx.x;
    unsigned char* ws = args.ws;
    const float* x = args.in[0]; const float* norm_g = args.in[1]; const float* w_in = args.in[2]; const float* b_forget = args.in[3];
    const float* lq1 = args.in[4]; const float* lk1 = args.in[5]; const float* lq2 = args.in[6]; const float* lk2 = args.in[7];
    const float* subln_g = args.in[8]; const float* w_out = args.in[9]; const float* final_g = args.in[10];
    float* out = args.out;
    unsigned* ctl = (unsigned*)(ws + WS_CTL); float* rowss = (float*)(ws + WS_CTL + CTL_ROWSS);
    bf16* Wt_in = (bf16*)(ws + WS_WIN); bf16* Wt_out = (bf16*)(ws + WS_WOUT); float* rope = (float*)(ws + WS_ROPE);
    float* LOGF = (float*)(ws + WS_LOGF); float* GC = (float*)(ws + WS_G);
    bf16* U = (bf16*)(ws + WS_U); bf16* MIXED = (bf16*)(ws + WS_U); bf16* PROJ = (bf16*)(ws + WS_PROJ); float* STASH = (float*)(ws + WS_STASH);
    const int lo = args.ph_lo, hi_ph = args.ph_hi;
#ifndef PH_MASK
#define PH_MASK 31
#endif
#define IN(k) (((PH_MASK >> (k)) & 1) && lo <= (k) && (k) < hi_ph)
#define GRID_SYNC(k) do { if (IN(k) && IN((k) + 1)) cg::this_grid().sync(); } while (0)

    if (IN(0)) {
        const int gw = bx * NWAVES + wave, NGW = G * NWAVES;
        LAS float* scr = (LAS float*)(lds + wave * 16384);
        constexpr int I_IN = (DM / 64) * (NPROJ / 32), I_OUT = (DM / 64) * (DM / 32);
        for (int it = gw; it < I_IN + I_OUT; it += NGW) {
            if (it < I_IN) transpose_item(w_in, NCOL_IN, DM, Wt_in, scr, it, NPROJ / 32, lane, true);
            else transpose_item(w_out, DM, DM, Wt_out, scr, it - I_IN, DM / 32, lane, false);
        }
        for (int idx = bx * (NWAVES * 64) + tid; idx < SEQ * 32; idx += G * NWAVES * 64) {
            const int pos = idx >> 5, i = idx & 31; const float ang = (float)pos * ROPE_INVF[i]; float c, s; sincos_acc(ang, c, s);
            *(float2*)(rope + (size_t)idx * 2) = make_float2(c, s);
        }
        __syncthreads();
        LAS float* wfz = (LAS float*)lds;
        for (int k = tid; k < DM; k += NWAVES * 64) { const int j = k >> 8, l = (k & 255) >> 2, e = k & 3; const float* src = w_in + (size_t)k * NCOL_IN + 2048;
            const f32x4 a = *(const f32x4*)src, b = *(const f32x4*)(src + 4); LAS f32x4* d = (LAS f32x4*)(wfz + ((j * 4 + e) * 64 + l) * 8); d[0] = a; d[1] = b; }
        __syncthreads();
        f32x4 gv[4];
#pragma unroll
        for (int j = 0; j < 4; ++j) gv[j] = ((const f32x4*)norm_g)[lane + 64 * j];
        const float bz = b_forget[lane & 7];
        for (int m = gw; m < SEQ; m += NGW) {
            const f32x4* xr = (const f32x4*)(x + (size_t)m * DM) + lane;
            f32x4 v[4]; float s2 = 0.f;
#pragma unroll
            for (int j = 0; j < 4; ++j) { v[j] = xr[64 * j]; s2 += (v[j].x * v[j].x + v[j].y * v[j].y) + (v[j].z * v[j].z + v[j].w * v[j].w); }
            const float rstd = 1.0f / sqrtf(wave_sum(s2) * (1.0f / DM) + EPS);
            unsigned long long* o8 = (unsigned long long*)(U + (size_t)m * DM) + lane;
            float za[8];
#pragma unroll
            for (int c = 0; c < 8; ++c) za[c] = 0.f;
#pragma unroll
            for (int j = 0; j < 4; ++j) { v[j] = v[j] * rstd * gv[j];
                o8[64 * j] = (unsigned long long)pk2(v[j].x, v[j].y) | ((unsigned long long)pk2(v[j].z, v[j].w) << 32);
#pragma unroll
                for (int e = 0; e < 4; ++e) { const LAS f32x4* wp = (const LAS f32x4*)(wfz + ((j * 4 + e) * 64 + lane) * 8); const f32x4 wa = wp[0], wb = wp[1]; const float uv = v[j][e];
                    za[0] += uv * wa.x; za[1] += uv * wa.y; za[2] += uv * wa.z; za[3] += uv * wa.w; za[4] += uv * wb.x; za[5] += uv * wb.y; za[6] += uv * wb.z; za[7] += uv * wb.w; } }
#pragma unroll
            for (int c = 0; c < 8; ++c) za[c] = wave_sum(za[c]);
            const int c = lane & 7;
            float z = (c == 0) ? za[0] : (c == 1) ? za[1] : (c == 2) ? za[2] : (c == 3) ? za[3] : (c == 4) ? za[4] : (c == 5) ? za[5] : (c == 6) ? za[6] : za[7];
            z += bz;
            const float ls = (z >= 0.f) ? -log1pf(expf(-z)) : z - log1pf(expf(z));
            if (lane < 8) LOGF[(size_t)c * SEQ + m] = ls * LOG2E;
        }
    }
    GRID_SYNC(0);

    if (IN(1)) {
        if (bx < 8) {
            const float* lf = LOGF + (size_t)bx * SEQ + tid * 32; float* gc = GC + (size_t)bx * SEQ + tid * 32;
            double p[32]; double run = 0.0;
#pragma unroll
            for (int q = 0; q < 8; ++q) { const f32x4 a = ((const f32x4*)lf)[q];
                run += (double)a.x; p[4 * q] = run; run += (double)a.y; p[4 * q + 1] = run; run += (double)a.z; p[4 * q + 2] = run; run += (double)a.w; p[4 * q + 3] = run; }
            double sc = run;
#pragma unroll
            for (int o = 1; o < 64; o <<= 1) { const double n = __shfl_up(sc, o); if (lane >= o) sc += n; }
            LAS double* wt = (LAS double*)lds;
            if (lane == 63) wt[wave] = sc;
            __syncthreads();
            double base = sc - run;
            for (int q = 0; q < wave; ++q) base += wt[q];
#pragma unroll
            for (int q = 0; q < 8; ++q) { f32x4 o; o.x = (float)(base + p[4 * q]); o.y = (float)(base + p[4 * q + 1]); o.z = (float)(base + p[4 * q + 2]); o.w = (float)(base + p[4 * q + 3]); ((f32x4*)gc)[q] = o; }
            __syncthreads();
        }
        pg8::Gemm g{U, Wt_in, SEQ, NPROJ, DM}; pg8::StaticOrder S; S.init(SEQ, NPROJ, G, bx);
        pg8::EpiProj E{PROJ, rope};
        pg8::gemm_phase<pg8::EpiProj, pg8::StaticOrder, true, true>(lds, g, S, E);
    }
    GRID_SYNC(1);

    if (IN(2)) {
        const float lam = __expf(wave_sum(lq1[lane] * lk1[lane])) - __expf(wave_sum(lq2[lane] * lk2[lane])) + 0.2f;
        for (;;) {
            if (tid == 0) MISC[0] = (int)atomicAdd(ctl + CW_QUEUE, 1u);
            __syncthreads();
            const int idx = MISC[0];
            __syncthreads();
            if (idx >= 768) break;
#ifndef NO_DIFF
            if (idx < 256) att::diff_unit(lds, PROJ, MIXED, STASH + (size_t)bx * 32768, lam, subln_g, idx & 3, 63 - (idx >> 2));
#endif
#ifndef NO_FOX
            if (idx >= 256) att::fox_unit(lds, PROJ, GC, MIXED, (idx - 256) & 7, 63 - ((idx - 256) >> 3));
#endif
        }
    }
    GRID_SYNC(2);

    if (IN(3)) {
        pg8::Gemm g{MIXED, Wt_out, SEQ, DM, DM}; pg8::StaticOrder S; S.init(SEQ, DM, G, bx);
        pg8::EpiOut E{x, out, rowss};
        pg8::gemm_phase<pg8::EpiOut, pg8::StaticOrder, false, true>(lds, g, S, E);
    }
    GRID_SYNC(3);

    if (IN(4)) {
        const int gw = bx * NWAVES + wave, NGW = G * NWAVES;
        f32x4 gv[4];
#pragma unroll
        for (int j = 0; j < 4; ++j) gv[j] = ((const f32x4*)final_g)[lane + 64 * j];
        for (int m = gw; m < SEQ; m += NGW) {
            const float rstd = 1.0f / sqrtf(rowss[m] * (1.0f / DM) + EPS);
            f32x4* hr = (f32x4*)(out + (size_t)m * DM) + lane;
#pragma unroll
            for (int j = 0; j < 4; ++j) hr[64 * j] = hr[64 * j] * rstd * gv[j];
        }
    }
#undef IN
#undef GRID_SYNC
}

extern "C" void kernel_launch(void* const* d_in, const int* in_sizes, int n_in, void* d_out, int out_size, void* d_ws, size_t ws_size, hipStream_t stream) {
    static int grid = 0;
    if (grid == 0) {
        if (n_in != 11 || in_sizes[0] != SEQ * DM || out_size != SEQ * DM || ws_size < WS_END) { fprintf(stderr, "kernel_launch: unexpected shapes (n_in %d, ws %zu)\n", n_in, ws_size); grid = -1; return; }
        int dev = 0, cus = 0, per_cu = 0;
        if (hipGetDevice(&dev) != hipSuccess || hipDeviceGetAttribute(&cus, hipDeviceAttributeMultiprocessorCount, dev) != hipSuccess) { grid = -1; return; }
        if (hipFuncSetAttribute((const void*)hymba_fwd, hipFuncAttributeMaxDynamicSharedMemorySize, LDS_BYTES) != hipSuccess) { fprintf(stderr, "kernel_launch: hipFuncSetAttribute failed\n"); grid = -1; return; }
        if (hipOccupancyMaxActiveBlocksPerMultiprocessor(&per_cu, (const void*)hymba_fwd, NWAVES * 64, LDS_BYTES) != hipSuccess || per_cu < 1) { fprintf(stderr, "kernel_launch: occupancy query says %d\n", per_cu); per_cu = 1; }
        (void)hipGetLastError();
        grid = cus;
    }
    if (grid < 0) return;
    (void)hipMemsetAsync((char*)d_ws + WS_CTL, 0, CTL_ZERO_BYTES, stream);
    Args a{};
    for (int i = 0; i < 11; ++i) a.in[i] = (const float*)d_in[i];
    a.out = (float*)d_out; a.ws = (unsigned char*)d_ws;
#if MK_N_LAUNCHES == 1
    a.ph_lo = 0; a.ph_hi = 5;
    void* kargs[] = {&a};
    hipError_t e = hipLaunchCooperativeKernel((const void*)hymba_fwd, dim3(grid), dim3(NWAVES * 64), kargs, LDS_BYTES, stream);
    if (e != hipSuccess) fprintf(stderr, "kernel_launch: cooperative launch failed: %s (grid %d)\n", hipGetErrorString(e), grid);
#else
    for (int ph = 0; ph < 5; ++ph) { a.ph_lo = ph; a.ph_hi = ph + 1; hipLaunchKernelGGL(hymba_fwd, dim3(grid), dim3(NWAVES * 64), LDS_BYTES, stream, a); }
#endif
}
```

```cpp
#include <hip/hip_runtime.h>
#include <hip/hip_cooperative_groups.h>
#include <cstdio>
#include <cstdint>
namespace cg = cooperative_groups;
#ifndef MK_N_LAUNCHES
#define MK_N_LAUNCHES 1
#endif
constexpr int SEQ = 16384, DM = 1024, NCOL_IN = 4104, NPROJ = 4096;
constexpr float LOG2E = 1.4426950408889634f;
constexpr float C2F = 0.125f * 1.4426950408889634f;
constexpr float EPS = 1e-6f;
namespace pg8 {
#define PG8_LAS __attribute__((address_space(3)))
typedef unsigned short bf16_t;
typedef short bf16x8 __attribute__((ext_vector_type(8)));
typedef float f32x4 __attribute__((ext_vector_type(4)));
typedef unsigned u32x4 __attribute__((ext_vector_type(4)));
constexpr int BM = 256, BK = 64, HALF = 128, HTB = HALF * BK * 2  , STAGE_BYTES = 8 * HTB, NXCD = 8, WGM = 8;

__host__ __device__ __forceinline__ int lds_byte(int r, int c) { const int st = (r >> 4) * 2 + (c >> 5), rr = r & 15, cc = c & 31, ob = rr * 64 + cc * 2; return st * 1024 + (ob ^ (((ob >> 9) & 1) << 5)); }
__host__ __device__ __forceinline__ void stage_rc(int b, int& R, int& C) { const int st = b / 1024, sb = b % 1024, swz = sb ^ (((sb >> 9) & 1) << 5); R = (st >> 1) * 16 + swz / 64; C = (st & 1) * 32 + (swz % 64) / 2; }
__host__ __device__ __forceinline__ int perm32(int rho) { const int n = rho >> 4, i = rho & 15; return 8 * (i >> 2) + 4 * n + (i & 3); }

struct Unit { int pm, pn; };
struct Gemm { const bf16_t* A; const bf16_t* Bt; int M, N, K; };

struct StaticOrder {
    int nM, nN, nwg, G, c;
    __host__ __device__ void init(int M, int N, int G_, int c_) { nM = M / BM; nN = N / BM; nwg = nM * nN; G = G_; c = c_; }
    __host__ __device__ bool next(int i, Unit& u) const {
        const long L = (long)i * G + c; if (L >= nwg) return false;
        int wgid = (int)L; { const int q = nwg / NXCD, r = nwg % NXCD, xcd = wgid % NXCD, off = wgid / NXCD; wgid = (xcd < r ? xcd * (q + 1) : r * (q + 1) + (xcd - r) * q) + off; }
        const int nig = WGM * nN, gid = wgid / nig, fm = gid * WGM, gsz = (nM - fm) < WGM ? (nM - fm) : WGM;
        u.pm = fm + ((wgid % nig) % gsz); u.pn = (wgid % nig) / gsz; return true;
    }
    __device__ __forceinline__ void a_ready(const Unit&) const {}
    __device__ __forceinline__ void done(const Unit&) const {}
};


typedef float f32x2 __attribute__((ext_vector_type(2)));
typedef __bf16 bf16x2_t __attribute__((ext_vector_type(2)));
__device__ __forceinline__ unsigned cvt_pk_bf16(float lo, float hi) { f32x2 v = {lo, hi}; bf16x2_t b = __builtin_convertvector(v, bf16x2_t); return __builtin_bit_cast(unsigned, b); }
__device__ __forceinline__ float silu_f(float v) { return v * __builtin_amdgcn_rcpf(1.0f + __builtin_amdgcn_exp2f(-LOG2E * v)); }

struct EpiProj {
    static constexpr bool PERM = true, AFTER_DRAIN = false;
    bf16_t* P; const float* rope;
    template <int MODE  >
    __device__ __forceinline__ void run(const f32x4 (&acc)[2][2][4][2], const Unit& u, int wr, int wc, int fr, int fq) const {
        const int row0 = u.pm * BM + wr * 64 + fr, within = 32 * (wc & 1) + 8 * fq, slot0 = 4 * u.pn + (wc >> 1);
#pragma unroll
        for (int ai = 0; ai < 2; ++ai)
#pragma unroll
            for (int m = 0; m < 4; ++m) {
                const int row = row0 + ai * HALF + m * 16;
                f32x4 c01 = {1.f, 0.f, 1.f, 0.f}, c23 = {1.f, 0.f, 1.f, 0.f};
                if (MODE >= 3) { const f32x4* rp = (const f32x4*)(rope + ((size_t)row * 32 + 16 * (wc & 1) + 4 * fq) * 2); c01 = rp[0]; c23 = rp[1]; }
#pragma unroll
                for (int bj = 0; bj < 2; ++bj) {
                    f32x4 v0 = acc[ai][bj][m][0], v1 = acc[ai][bj][m][1];
                    if (MODE >= 3) {
                        f32x4 r0, r1;
                        r0[0] = v0[0] * c01[0] - v0[1] * c01[1]; r0[1] = v0[1] * c01[0] + v0[0] * c01[1];
                        r0[2] = v0[2] * c01[2] - v0[3] * c01[3]; r0[3] = v0[3] * c01[2] + v0[2] * c01[3];
                        r1[0] = v1[0] * c23[0] - v1[1] * c23[1]; r1[1] = v1[1] * c23[0] + v1[0] * c23[1];
                        r1[2] = v1[2] * c23[2] - v1[3] * c23[3]; r1[3] = v1[3] * c23[2] + v1[2] * c23[3];
                        v0 = r0; v1 = r1;
                    }
                    if (MODE == 1 || MODE == 4) { v0 = v0 * C2F; v1 = v1 * C2F; }
                    if (MODE == 2) { v0[0] = silu_f(v0[0]); v0[1] = silu_f(v0[1]); v0[2] = silu_f(v0[2]); v0[3] = silu_f(v0[3]);
                                     v1[0] = silu_f(v1[0]); v1[1] = silu_f(v1[1]); v1[2] = silu_f(v1[2]); v1[3] = silu_f(v1[3]); }
                    u32x4 w; w.x = cvt_pk_bf16(v0[0], v0[1]); w.y = cvt_pk_bf16(v0[2], v0[3]); w.z = cvt_pk_bf16(v1[0], v1[1]); w.w = cvt_pk_bf16(v1[2], v1[3]);
                    *(u32x4*)(P + ((size_t)(slot0 + 2 * bj) * SEQ + row) * 64 + within) = w;
                }
            }
    }
    __device__ __forceinline__ void operator()(const f32x4 (&acc)[2][2][4][2], const Unit& u, int wr, int wc, int fr, int fq) const {
        const int g = u.pn >> 1;
        if (g == 0) run<1>(acc, u, wr, wc, fr, fq);
        else if (g == 3 || g == 7) run<2>(acc, u, wr, wc, fr, fq);
        else if (g == 4) run<4>(acc, u, wr, wc, fr, fq);
        else if (g == 5) run<3>(acc, u, wr, wc, fr, fq);
        else run<0>(acc, u, wr, wc, fr, fq);
    }
};

struct EpiOut {
    static constexpr bool PERM = false, AFTER_DRAIN = false;
    const float* x; float* out; float* rowss;
    __device__ __forceinline__ void operator()(const f32x4 (&acc)[2][2][4][2], const Unit& u, int wr, int wc, int fr, int fq) const {
        const int col0 = u.pn * BM + wc * 32 + 4 * fq;
#pragma unroll
        for (int ai = 0; ai < 2; ++ai)
#pragma unroll
            for (int m = 0; m < 4; ++m) {
                const int row = u.pm * BM + ai * HALF + wr * 64 + m * 16 + fr; const size_t off = (size_t)row * DM + col0; float ss = 0.f;
#pragma unroll
                for (int bj = 0; bj < 2; ++bj)
#pragma unroll
                    for (int n = 0; n < 2; ++n) { const f32x4 xv = *(const f32x4*)(x + off + bj * HALF + n * 16); const f32x4 h = xv + acc[ai][bj][m][n];
                        *(f32x4*)(out + off + bj * HALF + n * 16) = h; ss += (h[0] * h[0] + h[1] * h[1]) + (h[2] * h[2] + h[3] * h[3]); }
                ss += __shfl_xor(ss, 16); ss += __shfl_xor(ss, 32);
                if (fq == 0) unsafeAtomicAdd(rowss + row, ss);
            }
    }
};

template <class Epi, class Sched, bool ALIGN_EPI = false, bool SP2 = false>
__device__ __forceinline__ void gemm_phase(PG8_LAS unsigned char* lds, const Gemm g, const Sched& S, const Epi& E) {
    const int tid = threadIdx.x, wid = __builtin_amdgcn_readfirstlane(tid >> 6), lane = tid & 63, wr = wid >> 2, wc = wid & 3, fr = lane & 15, fq = lane >> 4;
    const int K = g.K, nt = K / BK;
    unsigned voffA[2], voffB[2];
#pragma unroll
    for (int i = 0; i < 2; ++i) { int R, C; stage_rc(tid * 16 + i * 8192, R, C); const int Rb = Epi::PERM ? ((R & ~31) + perm32(R & 31)) : R;
        voffA[i] = (unsigned)(R * K + C) * 2u; voffB[i] = (unsigned)(Rb * K + C) * 2u; }
    const size_t kstep = (size_t)(BK * 2);
    const size_t hstep = (size_t)HALF * K * 2;
    const size_t tstep = 2 * hstep;
    const unsigned ldsw = (unsigned)wid * 1024u;
    const int aoff = lds_byte(wr * 64 + fr, fq * 8), boff = lds_byte(wc * 32 + fr, fq * 8);
#define PG8_SA(b, h) (((b) * 2 + (h)) * HTB)
#define PG8_SB(b, h) ((4 + (b) * 2 + (h)) * HTB)
#define PG8_STAGE(bufoff, gbase, voff) do { _Pragma("unroll") for (int _i = 0; _i < 2; ++_i) \
        __builtin_amdgcn_global_load_lds((const unsigned*)((const char*)(gbase) + (voff)[_i]), (PG8_LAS unsigned*)(lds + (bufoff) + ldsw + _i * 8192), 16, 0, 0); } while (0)
#define PG8_LDA(dst, b, h) do { _Pragma("unroll") for (int m = 0; m < 4; ++m) _Pragma("unroll") for (int k = 0; k < 2; ++k) dst[m][k] = *(const PG8_LAS bf16x8*)(lds + PG8_SA(b, h) + aoff + m * 2048 + k * 1024); } while (0)
#define PG8_LDB(dst, b, h) do { _Pragma("unroll") for (int n = 0; n < 2; ++n) _Pragma("unroll") for (int k = 0; k < 2; ++k) dst[n][k] = *(const PG8_LAS bf16x8*)(lds + PG8_SB(b, h) + boff + n * 2048 + k * 1024); } while (0)
#define PG8_MMA(ai, bj, At, Bt) do { __builtin_amdgcn_s_setprio(1); _Pragma("unroll") for (int m = 0; m < 4; ++m) _Pragma("unroll") for (int n = 0; n < 2; ++n) _Pragma("unroll") for (int k = 0; k < 2; ++k) \
        acc[ai][bj][m][n] = __builtin_amdgcn_mfma_f32_16x16x32_bf16(Bt[n][k], At[m][k], acc[ai][bj][m][n], 0, 0, 0); __builtin_amdgcn_s_setprio(0); } while (0)
#define PG8_WAIT_V(n) asm volatile("s_waitcnt vmcnt(" #n ")" ::: "memory")
#define PG8_WAIT_L(n) asm volatile("s_waitcnt lgkmcnt(" #n ")" ::: "memory")
#define PG8_BAR __builtin_amdgcn_s_barrier()
#define PG8_SCHED __builtin_amdgcn_sched_barrier(0)
    Unit cur, nxt; int ui = 0;
    if (!S.next(0, cur)) return;
    f32x4 acc[2][2][4][2];
#pragma unroll
    for (int a = 0; a < 2; ++a)
#pragma unroll
        for (int b = 0; b < 2; ++b)
#pragma unroll
            for (int m = 0; m < 4; ++m)
#pragma unroll
                for (int n = 0; n < 2; ++n) acc[a][b][m][n] = (f32x4){0.f, 0.f, 0.f, 0.f};
    bf16x8 At[4][2], B0[2][2], B1[2][2];
    const char* cA = (const char*)g.A + (size_t)cur.pm * tstep; const char* cB = (const char*)g.Bt + (size_t)cur.pn * tstep;
    S.a_ready(cur);
    if constexpr (SP2) {
        PG8_STAGE(PG8_SB(0, 0), cB, voffB); PG8_STAGE(PG8_SB(0, 1), cB + hstep, voffB); PG8_STAGE(PG8_SA(0, 0), cA, voffA); PG8_STAGE(PG8_SA(0, 1), cA + hstep, voffA);
        if (wr == 1) PG8_BAR;
        PG8_WAIT_V(2); PG8_BAR;
        PG8_STAGE(PG8_SB(1, 0), cB + kstep, voffB); PG8_STAGE(PG8_SA(1, 0), cA + kstep, voffA); PG8_STAGE(PG8_SB(1, 1), cB + hstep + kstep, voffB);
        PG8_WAIT_V(6); PG8_BAR;
    } else {
        PG8_STAGE(PG8_SB(0, 0), cB, voffB); PG8_STAGE(PG8_SA(0, 0), cA, voffA); PG8_STAGE(PG8_SB(0, 1), cB + hstep, voffB); PG8_STAGE(PG8_SA(0, 1), cA + hstep, voffA);
        if (wr == 1) PG8_BAR;
        PG8_WAIT_V(4); PG8_BAR;
        PG8_STAGE(PG8_SB(1, 0), cB + kstep, voffB); PG8_STAGE(PG8_SA(1, 0), cA + kstep, voffA); PG8_STAGE(PG8_SB(1, 1), cB + hstep + kstep, voffB);
        PG8_WAIT_V(6); PG8_BAR;
    }
    for (;;) {
        const bool has_next = S.next(ui + 1, nxt);
        const char* nA = has_next ? (const char*)g.A + (size_t)nxt.pm * tstep : cA; const char* nB = has_next ? (const char*)g.Bt + (size_t)nxt.pn * tstep : cB;
        for (int t = 0; t < nt; t += 2) {
            const bool last = (t == nt - 2);
            const char* a1 = cA + (size_t)(t + 1) * kstep;
            const char* a2 = last ? nA : cA + (size_t)(t + 2) * kstep; const char* b2 = last ? nB : cB + (size_t)(t + 2) * kstep;
            const char* a3 = a2 + kstep; const char* b3 = b2 + kstep;
            if (last && has_next) S.a_ready(nxt);
            if constexpr (SP2) {
            PG8_LDB(B0, 0, 0); PG8_LDB(B1, 0, 1); PG8_SCHED; PG8_LDA(At, 0, 0); PG8_STAGE(PG8_SA(1, 1), a1 + hstep, voffA);
            PG8_WAIT_V(8); PG8_WAIT_L(0); PG8_BAR; PG8_MMA(0, 0, At, B0); PG8_MMA(0, 1, At, B1); PG8_BAR; PG8_SCHED;
            PG8_LDA(At, 0, 1); PG8_STAGE(PG8_SB(0, 0), b2, voffB); PG8_STAGE(PG8_SB(0, 1), b2 + hstep, voffB); PG8_STAGE(PG8_SA(0, 0), a2, voffA);
            PG8_WAIT_V(8); PG8_WAIT_L(0); PG8_BAR; PG8_MMA(1, 0, At, B0); PG8_MMA(1, 1, At, B1); PG8_BAR; PG8_SCHED;
            PG8_LDB(B0, 1, 0); PG8_LDB(B1, 1, 1); PG8_SCHED; PG8_LDA(At, 1, 0); PG8_STAGE(PG8_SA(0, 1), a2 + hstep, voffA);
            PG8_WAIT_V(8); PG8_WAIT_L(0); PG8_BAR; PG8_MMA(0, 0, At, B0); PG8_MMA(0, 1, At, B1); PG8_BAR; PG8_SCHED;
            PG8_LDA(At, 1, 1); PG8_STAGE(PG8_SB(1, 0), b3, voffB); PG8_STAGE(PG8_SB(1, 1), b3 + hstep, voffB); PG8_STAGE(PG8_SA(1, 0), a3, voffA);
            PG8_WAIT_V(8); PG8_WAIT_L(0); PG8_BAR; PG8_MMA(1, 0, At, B0); PG8_MMA(1, 1, At, B1); PG8_BAR; PG8_SCHED;
            } else {
            PG8_LDB(B0, 0, 0); PG8_SCHED; PG8_LDA(At, 0, 0); PG8_STAGE(PG8_SA(1, 1), a1 + hstep, voffA);
            PG8_WAIT_L(8); PG8_BAR; PG8_WAIT_L(0); PG8_MMA(0, 0, At, B0); PG8_BAR; PG8_SCHED;
            PG8_LDB(B1, 0, 1); PG8_STAGE(PG8_SB(0, 0), b2, voffB);
            PG8_BAR; PG8_WAIT_L(0); PG8_MMA(0, 1, At, B1); PG8_BAR;
            PG8_LDA(At, 0, 1); PG8_STAGE(PG8_SA(0, 0), a2, voffA);
            PG8_BAR; PG8_WAIT_L(0); PG8_MMA(1, 0, At, B0); PG8_BAR; PG8_SCHED;
            PG8_STAGE(PG8_SB(0, 1), b2 + hstep, voffB);
            PG8_WAIT_V(6); PG8_BAR; PG8_MMA(1, 1, At, B1); PG8_BAR;
            PG8_LDB(B0, 1, 0); PG8_SCHED; PG8_LDA(At, 1, 0); PG8_STAGE(PG8_SA(0, 1), a2 + hstep, voffA);
            PG8_WAIT_L(8); PG8_BAR; PG8_WAIT_L(0); PG8_MMA(0, 0, At, B0); PG8_BAR; PG8_SCHED;
            PG8_LDB(B1, 1, 1); PG8_STAGE(PG8_SB(1, 0), b3, voffB);
            PG8_BAR; PG8_WAIT_L(0); PG8_MMA(0, 1, At, B1); PG8_BAR;
            PG8_LDA(At, 1, 1); PG8_STAGE(PG8_SA(1, 0), a3, voffA);
            PG8_BAR; PG8_WAIT_L(0); PG8_MMA(1, 0, At, B0); PG8_BAR; PG8_SCHED;
            PG8_STAGE(PG8_SB(1, 1), b3 + hstep, voffB);
            PG8_WAIT_V(6); PG8_BAR; PG8_MMA(1, 1, At, B1); PG8_BAR;
            }
        }
        if constexpr (ALIGN_EPI) { if (wr == 0) PG8_BAR; }
        if constexpr (!Epi::AFTER_DRAIN) { E(acc, cur, wr, wc, fr, fq); S.done(cur); }
        if (!has_next) break;
#pragma unroll
        for (int a = 0; a < 2; ++a)
#pragma unroll
            for (int b = 0; b < 2; ++b)
#pragma unroll
                for (int m = 0; m < 4; ++m)
#pragma unroll
                    for (int n = 0; n < 2; ++n) acc[a][b][m][n] = (f32x4){0.f, 0.f, 0.f, 0.f};
        cur = nxt; cA = nA; cB = nB; ++ui;
        if constexpr (ALIGN_EPI) { if (wr == 1) PG8_BAR; }
    }
    PG8_WAIT_V(0);
    if constexpr (!ALIGN_EPI) { if (wr == 0) PG8_BAR; }
    PG8_BAR;
    if constexpr (Epi::AFTER_DRAIN) { E.fused(acc, cur, wr, wc, fr, fq, lds, wid, lane); S.done(cur); }
#undef PG8_SA
#undef PG8_SB
#undef PG8_STAGE
#undef PG8_LDA
#undef PG8_LDB
#undef PG8_MMA
#undef PG8_WAIT_V
#undef PG8_WAIT_L
#undef PG8_BAR
#undef PG8_SCHED
}
}

namespace att {
#define LAS __attribute__((address_space(3)))
typedef unsigned short bf16_t;
typedef short bf16x8 __attribute__((ext_vector_type(8)));
typedef short s16x4 __attribute__((ext_vector_type(4)));
typedef short v4i16_t __attribute__((ext_vector_type(4)));
typedef float f32x16 __attribute__((ext_vector_type(16)));
typedef float f32x4 __attribute__((ext_vector_type(4)));
typedef float f32x2 __attribute__((ext_vector_type(2)));
typedef unsigned u32x4 __attribute__((ext_vector_type(4)));
typedef __bf16 bf16x2_t __attribute__((ext_vector_type(2)));
constexpr int K_OFF = 0, V_OFF = 16384, G_OFF = 49152, FLAG_OFF = 49664, WSF_OFF = 50176, OST_OFF = 53248, ATT_BYTES = OST_OFF + 8 * 8192;
constexpr float THR = 8.0f;
__device__ __forceinline__ int crow(int r, int hi) { return (r & 3) + 8 * (r >> 2) + 4 * hi; }
__device__ __forceinline__ unsigned cvtpk(float lo, float hi) { f32x2 v = {lo, hi}; bf16x2_t b = __builtin_convertvector(v, bf16x2_t); return __builtin_bit_cast(unsigned, b); }
__device__ __forceinline__ void glds16(const void* g, unsigned lds_dst) { unsigned keep;
    asm volatile("s_mov_b32 %0, m0\n\ts_mov_b32 m0, %2\n\ts_nop 0\n\tglobal_load_lds_dwordx4 %1, off\n\ts_mov_b32 m0, %0" : "=&s"(keep) : "v"(g), "s"(lds_dst) : "memory"); }
__device__ __forceinline__ void glds4(const void* g, unsigned lds_dst) { unsigned keep;
    asm volatile("s_mov_b32 %0, m0\n\ts_mov_b32 m0, %2\n\ts_nop 0\n\tglobal_load_lds_dword %1, off\n\ts_mov_b32 m0, %0" : "=&s"(keep) : "v"(g), "s"(lds_dst) : "memory"); }
#define ATT_WAIT_BAR0() asm volatile("s_waitcnt vmcnt(0) lgkmcnt(0)\n\ts_barrier" ::: "memory")
#define ATT_MFMA(a, b, c) __builtin_amdgcn_mfma_f32_32x32x16_bf16(a, b, c, 0, 0, 0)
__device__ __forceinline__ s16x4 vtr(LAS const unsigned char* p) { return __builtin_bit_cast(s16x4, __builtin_amdgcn_ds_read_tr16_b64_v4i16((LAS v4i16_t*)p)); }
__device__ __forceinline__ float rowmax32(const f32x16& p0, const f32x16& p1) {
    float a = __builtin_fmaxf(p0[0], p1[0]);
#pragma unroll
    for (int r = 1; r < 16; ++r) a = __builtin_fmaxf(__builtin_fmaxf(a, p0[r]), p1[r]);
    auto rr = __builtin_amdgcn_permlane32_swap(__float_as_uint(a), __float_as_uint(a), false, false);
    return __builtin_fmaxf(__uint_as_float(rr[0]), __uint_as_float(rr[1]));
}
__device__ __forceinline__ float halfsum(float v) {
    auto rr = __builtin_amdgcn_permlane32_swap(__float_as_uint(v), __float_as_uint(v), false, false);
    return __uint_as_float(rr[0]) + __uint_as_float(rr[1]);
}

template <int DV, bool FOX>
__device__ __forceinline__ void attn_pass(LAS unsigned char* lds, const bf16_t* __restrict__ Qh, const bf16_t* __restrict__ Kh, const bf16_t* __restrict__ Va, const bf16_t* __restrict__ Vb,
                                          const float* __restrict__ Gh, int qb, f32x16 (&o)[DV / 32], float& l_out) {
    const int tid = threadIdx.x, lane = tid & 63, r32 = lane & 31, hi = lane >> 5;
    const int w = __builtin_amdgcn_readfirstlane(tid >> 6);
    const int q0 = qb * 256, NTu = 4 * qb + 4, my_nt = 4 * qb + (w >> 1) + 1;
    const unsigned lds0 = (unsigned)(uintptr_t)lds;
    LAS float* wsf = (LAS float*)(lds + WSF_OFF) + w * 64;
    const bf16_t* ksrc = Kh + (size_t)lane * 64 + w * 8;
    const size_t voff = (size_t)(16 * (w & 3) + (lane >> 2)) * 64 + (w >> 2) * 32 + (lane & 3) * 8;
    const bf16_t* vsrcA = Va + voff; const bf16_t* vsrcB = (DV == 128) ? Vb + voff : Va;
    const unsigned kdst = lds0 + K_OFF + w * 1024, vdstA = lds0 + V_OFF + w * 1024, vdstB = lds0 + V_OFF + (w + 8) * 1024, gdst = lds0 + G_OFF;
#define ATT_DMA(t, sl) do { const size_t to_ = (size_t)(t) * 4096; \
        glds16(ksrc + to_, (unsigned)__builtin_amdgcn_readfirstlane(kdst + (sl) * 8192)); \
        glds16(vsrcA + to_, (unsigned)__builtin_amdgcn_readfirstlane(vdstA + (sl) * 16384)); \
        if (DV == 128) glds16(vsrcB + to_, (unsigned)__builtin_amdgcn_readfirstlane(vdstB + (sl) * 16384)); \
        if (FOX) { if (w == 0) glds4(Gh + (size_t)(t) * 64 + lane, (unsigned)__builtin_amdgcn_readfirstlane(gdst + (sl) * 256)); } } while (0)
    ATT_DMA(FOX ? NTu - 1 : 0, 0);
    bf16x8 qr[4];
    { const bf16_t* Qw = Qh + (size_t)(q0 + 32 * w + r32) * 64 + hi * 8;
#pragma unroll
      for (int d0 = 0; d0 < 4; ++d0) qr[d0] = *(const bf16x8*)(Qw + d0 * 16); }
    const float gq = FOX ? Gh[q0 + 32 * w + r32] : 0.f;
    f32x16 cinit;
#pragma unroll
    for (int r = 0; r < 16; ++r) cinit[r] = gq;
    float l = 0.f;
#pragma unroll
    for (int d = 0; d < DV / 32; ++d)
#pragma unroll
        for (int r = 0; r < 16; ++r) o[d][r] = 0.f;
    bool first = true;
    for (int i = 0; i < NTu; ++i) {
        ATT_WAIT_BAR0();
        const int t = FOX ? NTu - 1 - i : i, sl = i & 1;
        if (i + 1 < NTu) ATT_DMA(FOX ? t - 1 : t + 1, sl ^ 1);
        if (t < my_nt) {
            LAS const unsigned char* kp = lds + K_OFF + sl * 8192 + hi * 1024 + r32 * 16;
            f32x16 p0, p1;
#pragma unroll
            for (int d0 = 0; d0 < 4; ++d0) {
                const bf16x8 b0 = *(LAS const bf16x8*)(kp + d0 * 2048), b1 = *(LAS const bf16x8*)(kp + d0 * 2048 + 512);
                if (d0 == 0) { p0 = ATT_MFMA(b0, qr[0], cinit); p1 = ATT_MFMA(b1, qr[0], cinit); }
                else { p0 = ATT_MFMA(b0, qr[d0], p0); p1 = ATT_MFMA(b1, qr[d0], p1); }
            }
            if (FOX) {
                LAS const float* gp = (LAS const float*)(lds + G_OFF + sl * 256) + 4 * hi;
#pragma unroll
                for (int g = 0; g < 4; ++g) { const f32x4 a = *(LAS const f32x4*)(gp + 8 * g), b = *(LAS const f32x4*)(gp + 32 + 8 * g);
#pragma unroll
                    for (int e = 0; e < 4; ++e) { p0[4 * g + e] -= a[e]; p1[4 * g + e] -= b[e]; } }
                if (t == my_nt - 1) {
                    const int lim = 32 * (w & 1) + r32;
#pragma unroll
                    for (int r = 0; r < 16; ++r) { const int kk = crow(r, hi); if (kk > lim) p0[r] = -INFINITY; if (kk + 32 > lim) p1[r] = -INFINITY; }
                }
            }
            const float rm = rowmax32(p0, p1);
            if (first || __any(rm > THR)) {
                const float dl = first ? rm : __builtin_fmaxf(rm, 0.f);
                p0 = p0 - dl; p1 = p1 - dl; cinit = cinit - dl;
                if (!first) {
                    const float f = __builtin_amdgcn_exp2f(-dl); l *= f;
                    if (hi == 0) wsf[r32] = f;
                    __builtin_amdgcn_fence(__ATOMIC_RELEASE, "wavefront");
#pragma unroll
                    for (int r = 0; r < 16; ++r) { const float fr_ = wsf[crow(r, hi)];
#pragma unroll
                        for (int d = 0; d < DV / 32; ++d) o[d][r] *= fr_; }
                }
                first = false;
            }
            float sacc = 0.f;
#pragma unroll
            for (int r = 0; r < 16; ++r) { p0[r] = __builtin_amdgcn_exp2f(p0[r]); p1[r] = __builtin_amdgcn_exp2f(p1[r]); sacc += p0[r] + p1[r]; }
            l += sacc;
            u32x4 pw[4];
#pragma unroll
            for (int s = 0; s < 2; ++s) {
                pw[s]     = (u32x4){cvtpk(p0[8 * s], p0[8 * s + 1]), cvtpk(p0[8 * s + 2], p0[8 * s + 3]), cvtpk(p0[8 * s + 4], p0[8 * s + 5]), cvtpk(p0[8 * s + 6], p0[8 * s + 7])};
                pw[2 + s] = (u32x4){cvtpk(p1[8 * s], p1[8 * s + 1]), cvtpk(p1[8 * s + 2], p1[8 * s + 3]), cvtpk(p1[8 * s + 4], p1[8 * s + 5]), cvtpk(p1[8 * s + 6], p1[8 * s + 7])};
            }
            LAS const unsigned char* vp = lds + V_OFF + sl * 16384 + ((lane >> 4) & 1) * 32 + (lane & 3) * 8 + (4 * hi + ((lane & 15) >> 2)) * 64;
#pragma unroll
            for (int d = 0; d < DV / 32; ++d)
#pragma unroll
                for (int s = 0; s < 4; ++s) {
                    const s16x4 lo = vtr(vp + d * 4096 + s * 1024), hh = vtr(vp + d * 4096 + s * 1024 + 512);
                    const bf16x8 vf = (bf16x8){lo[0], lo[1], lo[2], lo[3], hh[0], hh[1], hh[2], hh[3]};
                    o[d] = ATT_MFMA(__builtin_bit_cast(bf16x8, pw[s]), vf, o[d]);
                }
        }
    }
    ATT_WAIT_BAR0();
    l_out = halfsum(l);
#undef ATT_DMA
}

__device__ __forceinline__ void row_recip(LAS float* wsf, float l, int r32, int hi, float (&rli)[16]) {
    if (hi == 0) wsf[32 + r32] = l;
    __builtin_amdgcn_fence(__ATOMIC_RELEASE, "wavefront");
#pragma unroll
    for (int r = 0; r < 16; ++r) rli[r] = __builtin_amdgcn_rcpf(wsf[32 + crow(r, hi)]);
}
__device__ __forceinline__ void stage_gate_store(LAS float* stg, const f32x16& a0, const f32x16& a1, int lane, int r32, int hi,
                                                 const bf16_t* __restrict__ gate  , bf16_t* __restrict__ outp  ) {
#pragma unroll
    for (int r = 0; r < 16; ++r) { const int orow = crow(r, hi); stg[orow * 64 + r32] = a0[r]; stg[orow * 64 + 32 + r32] = a1[r]; }
    __builtin_amdgcn_fence(__ATOMIC_RELEASE, "wavefront");
#pragma unroll
    for (int i = 0; i < 4; ++i) {
        const int row = i * 8 + (lane >> 3), ch = lane & 7;
        const f32x4 x0 = *(LAS const f32x4*)(stg + row * 64 + ch * 8), x1 = *(LAS const f32x4*)(stg + row * 64 + ch * 8 + 4);
        const u32x4 gv = *(const u32x4*)(gate + (size_t)row * 64 + ch * 8);
        u32x4 ov;
        ov.x = cvtpk(x0[0] * __uint_as_float(gv.x << 16), x0[1] * __uint_as_float(gv.x & 0xffff0000u));
        ov.y = cvtpk(x0[2] * __uint_as_float(gv.y << 16), x0[3] * __uint_as_float(gv.y & 0xffff0000u));
        ov.z = cvtpk(x1[0] * __uint_as_float(gv.z << 16), x1[1] * __uint_as_float(gv.z & 0xffff0000u));
        ov.w = cvtpk(x1[2] * __uint_as_float(gv.w << 16), x1[3] * __uint_as_float(gv.w & 0xffff0000u));
        *(u32x4*)(outp + (size_t)row * DM + ch * 8) = ov;
    }
    __builtin_amdgcn_fence(__ATOMIC_RELEASE, "wavefront");
}

__device__ __forceinline__ const bf16_t* slot_ptr(const bf16_t* P, int s) { return P + (size_t)s * SEQ * 64; }

__device__ __forceinline__ void fox_unit(LAS unsigned char* lds, const bf16_t* P, const float* G, bf16_t* MIXED, int h, int qb) {
    const int tid = threadIdx.x, lane = tid & 63, r32 = lane & 31, hi = lane >> 5; const int w = __builtin_amdgcn_readfirstlane(tid >> 6);
    f32x16 o[2]; float l;
    attn_pass<64, true>(lds, slot_ptr(P, h), slot_ptr(P, 8 + h), slot_ptr(P, 16 + h), nullptr, G + (size_t)h * SEQ, qb, o, l);
    LAS float* wsf = (LAS float*)(lds + WSF_OFF) + w * 64; float rli[16];
    row_recip(wsf, l, r32, hi, rli);
#pragma unroll
    for (int r = 0; r < 16; ++r) { o[0][r] *= rli[r]; o[1][r] *= rli[r]; }
    const int row0 = qb * 256 + 32 * w;
    stage_gate_store((LAS float*)(lds + OST_OFF + w * 8192), o[0], o[1], lane, r32, hi, slot_ptr(P, 24 + h) + (size_t)row0 * 64, MIXED + (size_t)row0 * DM + h * 64);
}

__device__ __forceinline__ void diff_unit(LAS unsigned char* lds, const bf16_t* P, bf16_t* MIXED, float* stash, float lam, const float* __restrict__ subln_g, int hd, int qb) {
    const int tid = threadIdx.x, lane = tid & 63, r32 = lane & 31, hi = lane >> 5; const int w = __builtin_amdgcn_readfirstlane(tid >> 6);
    LAS float* wsf = (LAS float*)(lds + WSF_OFF) + w * 64; float rli[16];
    f32x16 o[4]; float l;
    f32x4* st = (f32x4*)(stash + ((size_t)w * 64 + lane) * 64);
    attn_pass<128, false>(lds, slot_ptr(P, 32 + 2 * hd), slot_ptr(P, 40 + 2 * hd), slot_ptr(P, 48 + 2 * hd), slot_ptr(P, 49 + 2 * hd), nullptr, qb, o, l);
    row_recip(wsf, l, r32, hi, rli);
#pragma unroll
    for (int d = 0; d < 4; ++d)
#pragma unroll
        for (int r4 = 0; r4 < 4; ++r4) st[d * 4 + r4] = (f32x4){o[d][4 * r4] * rli[4 * r4], o[d][4 * r4 + 1] * rli[4 * r4 + 1], o[d][4 * r4 + 2] * rli[4 * r4 + 2], o[d][4 * r4 + 3] * rli[4 * r4 + 3]};
    attn_pass<128, false>(lds, slot_ptr(P, 33 + 2 * hd), slot_ptr(P, 41 + 2 * hd), slot_ptr(P, 48 + 2 * hd), slot_ptr(P, 49 + 2 * hd), nullptr, qb, o, l);
    row_recip(wsf, l, r32, hi, rli);
    float ss[16];
#pragma unroll
    for (int r = 0; r < 16; ++r) { rli[r] *= lam; ss[r] = 0.f; }
#pragma unroll
    for (int d = 0; d < 4; ++d) {
#pragma unroll
        for (int r4 = 0; r4 < 4; ++r4) { const f32x4 sv = st[d * 4 + r4];
#pragma unroll
            for (int e = 0; e < 4; ++e) { const int r = 4 * r4 + e; const float v = sv[e] - o[d][r] * rli[r]; o[d][r] = v; ss[r] += v * v; } }
        asm volatile("" ::: "memory");
    }
#pragma unroll
    for (int r = 0; r < 16; ++r) { float s_ = ss[r]; s_ += __shfl_xor(s_, 1); s_ += __shfl_xor(s_, 2); s_ += __shfl_xor(s_, 4); s_ += __shfl_xor(s_, 8); s_ += __shfl_xor(s_, 16);
        ss[r] = __builtin_amdgcn_rsqf(s_ * (1.0f / 128.0f) + EPS) * 0.8f; }
#pragma unroll
    for (int d = 0; d < 4; ++d) { const float gs = subln_g[32 * d + r32];
#pragma unroll
        for (int r = 0; r < 16; ++r) o[d][r] *= ss[r] * gs; }
    const int row0 = qb * 256 + 32 * w;
    LAS float* stg = (LAS float*)(lds + OST_OFF + w * 8192);
    stage_gate_store(stg, o[0], o[1], lane, r32, hi, slot_ptr(P, 56 + 2 * hd) + (size_t)row0 * 64, MIXED + (size_t)row0 * DM + 512 + hd * 128);
    stage_gate_store(stg, o[2], o[3], lane, r32, hi, slot_ptr(P, 57 + 2 * hd) + (size_t)row0 * 64, MIXED + (size_t)row0 * DM + 512 + hd * 128 + 64);
}
#undef LAS
}
#define LAS __attribute__((address_space(3)))
#define XB_TMO      128
#define XB_XCNT(j)  (256  + 64 * (j))
#define XB_XSUB(j)  (1280 + 64 * (j))
#define XB_XGEN(j)  (2304 + 64 * (j))
#define XB_TOP      3328
#define XB_TOPGEN   3392
#define XCD_BAR_WORDS 3456
#define XB_SPIN_CAP (1u << 18)

__device__ __forceinline__ unsigned xb_ld(unsigned* p)              { return __hip_atomic_load(p, __ATOMIC_RELAXED, __HIP_MEMORY_SCOPE_AGENT); }
__device__ __forceinline__ unsigned xb_add(unsigned* p, unsigned v) { return __hip_atomic_fetch_add(p, v, __ATOMIC_RELAXED, __HIP_MEMORY_SCOPE_AGENT); }
__device__ __forceinline__ unsigned xb_xcc_id() { return (unsigned)__builtin_amdgcn_s_getreg((3 << 11) | 20) & 0xFu; }
#define XB_SPIN(cond, bar) do { unsigned _sp = 0; while (cond) { __builtin_amdgcn_s_sleep(1); \
    if ((++_sp & 255u) == 0u) { if (xb_ld(&(bar)[XB_TMO])) break; if (_sp > XB_SPIN_CAP) { atomicAdd(&(bar)[XB_TMO], 1u); break; } } } } while (0)

struct XcdBarrier {
    unsigned* bar; unsigned x;
    volatile LAS unsigned* st;
};

__device__ __forceinline__ XcdBarrier xcd_barrier_post(unsigned* bar, volatile LAS unsigned* st) {
    XcdBarrier b; b.bar = bar; b.x = xb_xcc_id(); b.st = st;
    if (threadIdx.x == 0) (void)xb_add(&bar[XB_XCNT(b.x)], 1u);
    return b;
}
__device__ __forceinline__ void xcd_barrier_complete(unsigned* bar, unsigned x, unsigned& nloc, unsigned& nx) {
    const unsigned G = gridDim.x * gridDim.y * gridDim.z;
    unsigned sum, cnt, mine, sp = 0u;
    for (;;) {
        sum = 0u; cnt = 0u; mine = 0u;
#pragma unroll
        for (unsigned j = 0; j < 16; ++j) { const unsigned c = xb_ld(&bar[XB_XCNT(j)]); sum += c; cnt += (c > 0u) ? 1u : 0u; mine = (j == x) ? c : mine; }
        if (sum == G) break;
        __builtin_amdgcn_s_sleep(1);
        if ((++sp & 255u) == 0u) { if (xb_ld(&bar[XB_TMO])) break; if (sp > XB_SPIN_CAP) { atomicAdd(&bar[XB_TMO], 1u); break; } }
    }
    nloc = mine > 0u ? mine : 1u; nx = cnt > 0u ? cnt : 1u;
}

__device__ __forceinline__ void xcd_barrier(const XcdBarrier& b) {
    asm volatile("s_waitcnt vmcnt(0)" ::: "memory");
    __syncthreads();
    if (threadIdx.x == 0) {
        unsigned* bar = b.bar;
        __builtin_amdgcn_s_waitcnt(0);
        unsigned nloc = b.st[0], nx = b.st[1];
        if (nloc == 0u) { xcd_barrier_complete(bar, b.x, nloc, nx); b.st[0] = nloc; b.st[1] = nx; }
        const unsigned old = xb_add(&bar[XB_XSUB(b.x)], 1u);
        const unsigned gen = old / nloc;
        if (old + 1u == (gen + 1u) * nloc) {
            __builtin_amdgcn_fence(__ATOMIC_RELEASE, "agent");
            asm volatile("s_waitcnt vmcnt(0)" ::: "memory");
            const unsigned og = xb_add(&bar[XB_TOP], 1u);
            const unsigned tg = og / nx;
            if (og + 1u == (tg + 1u) * nx) xb_add(&bar[XB_TOPGEN], 1u);
            else XB_SPIN(xb_ld(&bar[XB_TOPGEN]) == tg, bar);
            __builtin_amdgcn_fence(__ATOMIC_ACQUIRE, "agent");
            xb_add(&bar[XB_XGEN(b.x)], 1u);
            asm volatile("s_waitcnt vmcnt(0)" ::: "memory");
        } else {
            XB_SPIN(xb_ld(&bar[XB_XGEN(b.x)]) == gen, bar);
            __builtin_amdgcn_fence(__ATOMIC_ACQUIRE, "agent");
            asm volatile("s_waitcnt vmcnt(0)" ::: "memory");
        }
    }
    __syncthreads();
}
#undef LAS

#define LAS __attribute__((address_space(3)))
typedef unsigned short bf16;
typedef float f32x4 __attribute__((ext_vector_type(4)));
typedef unsigned v4u __attribute__((ext_vector_type(4)));
constexpr int NWAVES = 8;
constexpr size_t MiB = 1u << 20;
constexpr size_t WS_CTL = 0, CTL_ZERO_BYTES = 1 * MiB;
constexpr size_t WS_WIN = 1 * MiB;
constexpr size_t WS_WOUT = 9 * MiB;
constexpr size_t WS_ROPE = 11 * MiB;
constexpr size_t WS_LOGF = 15 * MiB;
constexpr size_t WS_G = 15 * MiB + 512 * 1024;
constexpr size_t WS_U = 16 * MiB;
constexpr size_t WS_PROJ = 48 * MiB;
constexpr size_t WS_STASH = 176 * MiB;
constexpr size_t WS_END = 208 * MiB;
constexpr int CW_QUEUE = 0, CW_BAR = 4096;
#ifndef USE_CG_SYNC
#define USE_CG_SYNC 0
#endif
constexpr size_t CTL_ROWSS = 65536;
constexpr int RING_BYTES = 131072, MISC_OFF = RING_BYTES, LDS_BYTES = 147456;
static_assert(att::ATT_BYTES <= RING_BYTES, "attention LDS map");

__device__ __forceinline__ unsigned f2bf(float f) { unsigned u = __builtin_bit_cast(unsigned, f); return (u + 0x7fffu + ((u >> 16) & 1u)) >> 16; }
__device__ __forceinline__ unsigned pk2(float lo, float hi) { return f2bf(lo) | (f2bf(hi) << 16); }
__device__ __forceinline__ float wave_sum(float v) {
#pragma unroll
    for (int o = 1; o < 64; o <<= 1) v += __shfl_xor(v, o);
    return v;
}
__device__ __forceinline__ int orig_col(int n) {
    const int g = n >> 9, wi = n & 511; const int base = g * 512 + (g >= 4 ? 8 : 0);
    if (g == 4 || g == 5) { const int head = wi >> 6, j = wi & 63; return base + head * 64 + (j >> 1) + 32 * (j & 1); }
    return base + wi;
}
__device__ __forceinline__ void transpose_item(const float* __restrict__ W, int ldw, int K, bf16* __restrict__ WT, LAS float* scr, int item, int nblk, int lane, bool permuted) {
    const int kb = item / nblk, nb = item % nblk, k0 = 64 * kb, n0 = 32 * nb;
    const int col = permuted ? orig_col(n0 + (lane & 31)) : n0 + (lane & 31);
#pragma unroll 8
    for (int i = 0; i < 32; ++i) { const int kk = 2 * i + (lane >> 5); scr[kk * 33 + (lane & 31)] = W[(size_t)(k0 + kk) * ldw + col]; }
    asm volatile("s_waitcnt lgkmcnt(0)" ::: "memory");
    const int c = lane & 7;
#pragma unroll
    for (int j = 0; j < 4; ++j) { const int n = (lane >> 3) + 8 * j; const LAS float* s = scr + (8 * c) * 33 + n;
        v4u o; o.x = pk2(s[0 * 33], s[1 * 33]); o.y = pk2(s[2 * 33], s[3 * 33]); o.z = pk2(s[4 * 33], s[5 * 33]); o.w = pk2(s[6 * 33], s[7 * 33]);
        *(v4u*)(WT + (size_t)(n0 + n) * K + k0 + 8 * c) = o; }
    asm volatile("s_waitcnt lgkmcnt(0)" ::: "memory");
}
__device__ const float ROPE_INVF[32] = {
    1.000000000e+00f, 7.498942018e-01f, 5.623413324e-01f, 4.216965139e-01f, 3.162277639e-01f, 2.371373773e-01f, 1.778279394e-01f, 1.333521456e-01f,
    1.000000015e-01f, 7.498942316e-02f, 5.623413250e-02f, 4.216964915e-02f, 3.162277490e-02f, 2.371373773e-02f, 1.778279431e-02f, 1.333521400e-02f,
    9.999999776e-03f, 7.498942316e-03f, 5.623413250e-03f, 4.216964822e-03f, 3.162277630e-03f, 2.371373819e-03f, 1.778279431e-03f, 1.333521446e-03f,
    1.000000047e-03f, 7.498941850e-04f, 5.623413017e-04f, 4.216965172e-04f, 3.162277571e-04f, 2.371373703e-04f, 1.778279402e-04f, 1.333521504e-04f };
__device__ __forceinline__ void sincos_acc(float ang, float& c, float& s) {
    const double x = (double)ang; const double kq = __builtin_rint(x * 0.63661977236758134308);
    double r = __builtin_fma(-kq, 1.57079632679489655800, x); r = __builtin_fma(-kq, 6.12323399573676603587e-17, r);
    const double r2 = r * r;
    double sp = -1.0 / 1307674368000.0; sp = sp * r2 + 1.0 / 6227020800.0; sp = sp * r2 - 1.0 / 39916800.0; sp = sp * r2 + 1.0 / 362880.0; sp = sp * r2 - 1.0 / 5040.0; sp = sp * r2 + 1.0 / 120.0; sp = sp * r2 - 1.0 / 6.0;
    const double sn = r + r * r2 * sp;
    double cp = 1.0 / 20922789888000.0; cp = cp * r2 - 1.0 / 87178291200.0; cp = cp * r2 + 1.0 / 479001600.0; cp = cp * r2 - 1.0 / 3628800.0; cp = cp * r2 + 1.0 / 40320.0; cp = cp * r2 - 1.0 / 720.0; cp = cp * r2 + 1.0 / 24.0; cp = cp * r2 - 0.5;
    const double cs = 1.0 + r2 * cp;
    const int q = ((int)kq) & 3;
    const double co = (q == 0) ? cs : (q == 1) ? -sn : (q == 2) ? -cs : sn;
    const double so = (q == 0) ? sn : (q == 1) ? cs : (q == 2) ? -sn : -cs;
    c = (float)co; s = (float)so;
}

struct Args { const float* in[11]; float* out; unsigned char* ws; int ph_lo, ph_hi; };

__global__ void __launch_bounds__(NWAVES * 64, 2) hymba_fwd(Args args) {
    extern __shared__ __attribute__((aligned(16))) unsigned char lds_raw[];
    LAS unsigned char* lds = (LAS unsigned char*)lds_raw;
    volatile LAS int* MISC = (volatile LAS int*)(lds + MISC_OFF);
    const int tid = threadIdx.x, lane = tid & 63, wave = __builtin_amdgcn_readfirstlane(tid >> 6);
    const int G = gridDim.x, bx = blockIdx.x;
    unsigned char* ws = args.ws;
    const float* x = args.in[0]; const float* norm_g = args.in[1]; const float* w_in = args.in[2]; const float* b_forget = args.in[3];
    const float* lq1 = args.in[4]; const float* lk1 = args.in[5]; const float* lq2 = args.in[6]; const float* lk2 = args.in[7];
    const float* subln_g = args.in[8]; const float* w_out = args.in[9]; const float* final_g = args.in[10];
    float* out = args.out;
    unsigned* ctl = (unsigned*)(ws + WS_CTL); float* rowss = (float*)(ws + WS_CTL + CTL_ROWSS);
    bf16* Wt_in = (bf16*)(ws + WS_WIN); bf16* Wt_out = (bf16*)(ws + WS_WOUT); float* rope = (float*)(ws + WS_ROPE);
    float* LOGF = (float*)(ws + WS_LOGF); float* GC = (float*)(ws + WS_G);
    bf16* U = (bf16*)(ws + WS_U); bf16* MIXED = (bf16*)(ws + WS_U); bf16* PROJ = (bf16*)(ws + WS_PROJ); float* STASH = (float*)(ws + WS_STASH);
    const int lo = args.ph_lo, hi_ph = args.ph_hi;
#ifndef PH_MASK
#define PH_MASK 31
#endif
#define IN(k) (((PH_MASK >> (k)) & 1) && lo <= (k) && (k) < hi_ph)
#if USE_CG_SYNC
#define GRID_SYNC(k) do { if (IN(k) && IN((k) + 1)) cg::this_grid().sync(); } while (0)
#else
    for (int u_ = tid; u_ < 64; u_ += NWAVES * 64) ((LAS unsigned*)(lds + MISC_OFF))[u_] = 0u;
    __syncthreads();
    XcdBarrier bar = xcd_barrier_post(ctl + CW_BAR, (volatile LAS unsigned*)(lds + MISC_OFF) + 8);
#define GRID_SYNC(k) do { if (IN(k) && IN((k) + 1)) xcd_barrier(bar); } while (0)
#endif

    if (IN(0)) {
        const int gw = bx * NWAVES + wave, NGW = G * NWAVES;
        LAS float* scr = (LAS float*)(lds + wave * 16384);
        constexpr int I_IN = (DM / 64) * (NPROJ / 32), I_OUT = (DM / 64) * (DM / 32);
        for (int it = gw; it < I_IN + I_OUT; it += NGW) {
            if (it < I_IN) transpose_item(w_in, NCOL_IN, DM, Wt_in, scr, it, NPROJ / 32, lane, true);
            else transpose_item(w_out, DM, DM, Wt_out, scr, it - I_IN, DM / 32, lane, false);
        }
        for (int idx = bx * (NWAVES * 64) + tid; idx < SEQ * 32; idx += G * NWAVES * 64) {
            const int pos = idx >> 5, i = idx & 31; const float ang = (float)pos * ROPE_INVF[i]; float c, s; sincos_acc(ang, c, s);
            *(float2*)(rope + (size_t)idx * 2) = make_float2(c, s);
        }
        __syncthreads();
        LAS float* wfz = (LAS float*)lds;
        for (int k = tid; k < DM; k += NWAVES * 64) { const int j = k >> 8, l = (k & 255) >> 2, e = k & 3; const float* src = w_in + (size_t)k * NCOL_IN + 2048;
            const f32x4 a = *(const f32x4*)src, b = *(const f32x4*)(src + 4); LAS f32x4* d = (LAS f32x4*)(wfz + ((j * 4 + e) * 64 + l) * 8); d[0] = a; d[1] = b; }
        __syncthreads();
        f32x4 gv[4];
#pragma unroll
        for (int j = 0; j < 4; ++j) gv[j] = ((const f32x4*)norm_g)[lane + 64 * j];
        const float bz = b_forget[lane & 7];
        for (int m = gw; m < SEQ; m += NGW) {
            const f32x4* xr = (const f32x4*)(x + (size_t)m * DM) + lane;
            f32x4 v[4]; float s2 = 0.f;
#pragma unroll
            for (int j = 0; j < 4; ++j) { v[j] = xr[64 * j]; s2 += (v[j].x * v[j].x + v[j].y * v[j].y) + (v[j].z * v[j].z + v[j].w * v[j].w); }
            const float rstd = 1.0f / sqrtf(wave_sum(s2) * (1.0f / DM) + EPS);
            unsigned long long* o8 = (unsigned long long*)(U + (size_t)m * DM) + lane;
            float za[8];
#pragma unroll
            for (int c = 0; c < 8; ++c) za[c] = 0.f;
#pragma unroll
            for (int j = 0; j < 4; ++j) { v[j] = v[j] * rstd * gv[j];
                o8[64 * j] = (unsigned long long)pk2(v[j].x, v[j].y) | ((unsigned long long)pk2(v[j].z, v[j].w) << 32);
#pragma unroll
                for (int e = 0; e < 4; ++e) { const LAS f32x4* wp = (const LAS f32x4*)(wfz + ((j * 4 + e) * 64 + lane) * 8); const f32x4 wa = wp[0], wb = wp[1]; const float uv = v[j][e];
                    za[0] += uv * wa.x; za[1] += uv * wa.y; za[2] += uv * wa.z; za[3] += uv * wa.w; za[4] += uv * wb.x; za[5] += uv * wb.y; za[6] += uv * wb.z; za[7] += uv * wb.w; } }
#pragma unroll
            for (int c = 0; c < 8; ++c) za[c] = wave_sum(za[c]);
            const int c = lane & 7;
            float z = (c == 0) ? za[0] : (c == 1) ? za[1] : (c == 2) ? za[2] : (c == 3) ? za[3] : (c == 4) ? za[4] : (c == 5) ? za[5] : (c == 6) ? za[6] : za[7];
            z += bz;
            const float ls = (z >= 0.f) ? -log1pf(expf(-z)) : z - log1pf(expf(z));
            if (lane < 8) LOGF[(size_t)c * SEQ + m] = ls * LOG2E;
        }
    }
    GRID_SYNC(0);

    if (IN(1)) {
        if (bx < 8) {
            const float* lf = LOGF + (size_t)bx * SEQ + tid * 32; float* gc = GC + (size_t)bx * SEQ + tid * 32;
            double p[32]; double run = 0.0;
#pragma unroll
            for (int q = 0; q < 8; ++q) { const f32x4 a = ((const f32x4*)lf)[q];
                run += (double)a.x; p[4 * q] = run; run += (double)a.y; p[4 * q + 1] = run; run += (double)a.z; p[4 * q + 2] = run; run += (double)a.w; p[4 * q + 3] = run; }
            double sc = run;
#pragma unroll
            for (int o = 1; o < 64; o <<= 1) { const double n = __shfl_up(sc, o); if (lane >= o) sc += n; }
            LAS double* wt = (LAS double*)lds;
            if (lane == 63) wt[wave] = sc;
            __syncthreads();
            double base = sc - run;
            for (int q = 0; q < wave; ++q) base += wt[q];
#pragma unroll
            for (int q = 0; q < 8; ++q) { f32x4 o; o.x = (float)(base + p[4 * q]); o.y = (float)(base + p[4 * q + 1]); o.z = (float)(base + p[4 * q + 2]); o.w = (float)(base + p[4 * q + 3]); ((f32x4*)gc)[q] = o; }
            __syncthreads();
        }
        pg8::Gemm g{U, Wt_in, SEQ, NPROJ, DM}; pg8::StaticOrder S; S.init(SEQ, NPROJ, G, bx);
        pg8::EpiProj E{PROJ, rope};
        pg8::gemm_phase<pg8::EpiProj, pg8::StaticOrder, true, true>(lds, g, S, E);
    }
    GRID_SYNC(1);

    if (IN(2)) {
        const float lam = __expf(wave_sum(lq1[lane] * lk1[lane])) - __expf(wave_sum(lq2[lane] * lk2[lane])) + 0.2f;
        for (;;) {
            if (tid == 0) MISC[0] = (int)atomicAdd(ctl + CW_QUEUE, 1u);
            __syncthreads();
            const int idx = MISC[0];
            __syncthreads();
            if (idx >= 768) break;
#ifndef NO_DIFF
            if (idx < 256) att::diff_unit(lds, PROJ, MIXED, STASH + (size_t)bx * 32768, lam, subln_g, idx & 3, 63 - (idx >> 2));
#endif
#ifndef NO_FOX
            if (idx >= 256) att::fox_unit(lds, PROJ, GC, MIXED, (idx - 256) & 7, 63 - ((idx - 256) >> 3));
#endif
        }
    }
    GRID_SYNC(2);

    if (IN(3)) {
        pg8::Gemm g{MIXED, Wt_out, SEQ, DM, DM}; pg8::StaticOrder S; S.init(SEQ, DM, G, bx);
        pg8::EpiOut E{x, out, rowss};
        pg8::gemm_phase<pg8::EpiOut, pg8::StaticOrder, false, true>(lds, g, S, E);
    }
    GRID_SYNC(3);

    if (IN(4)) {
        const int gw = bx * NWAVES + wave, NGW = G * NWAVES;
        f32x4 gv[4];
#pragma unroll
        for (int j = 0; j < 4; ++j) gv[j] = ((const f32x4*)final_g)[lane + 64 * j];
        for (int m = gw; m < SEQ; m += NGW) {
            const float rstd = 1.0f / sqrtf(rowss[m] * (1.0f / DM) + EPS);
            f32x4* hr = (f32x4*)(out + (size_t)m * DM) + lane;
#pragma unroll
            for (int j = 0; j < 4; ++j) hr[64 * j] = hr[64 * j] * rstd * gv[j];
        }
    }
#undef IN
#undef GRID_SYNC
}

extern "C" void kernel_launch(void* const* d_in, const int* in_sizes, int n_in, void* d_out, int out_size, void* d_ws, size_t ws_size, hipStream_t stream) {
    static int grid = 0;
    if (grid == 0) {
        if (n_in != 11 || in_sizes[0] != SEQ * DM || out_size != SEQ * DM || ws_size < WS_END) { fprintf(stderr, "kernel_launch: unexpected shapes (n_in %d, ws %zu)\n", n_in, ws_size); grid = -1; return; }
        int dev = 0, cus = 0, per_cu = 0;
        if (hipGetDevice(&dev) != hipSuccess || hipDeviceGetAttribute(&cus, hipDeviceAttributeMultiprocessorCount, dev) != hipSuccess) { grid = -1; return; }
        if (hipFuncSetAttribute((const void*)hymba_fwd, hipFuncAttributeMaxDynamicSharedMemorySize, LDS_BYTES) != hipSuccess) { fprintf(stderr, "kernel_launch: hipFuncSetAttribute failed\n"); grid = -1; return; }
        if (hipOccupancyMaxActiveBlocksPerMultiprocessor(&per_cu, (const void*)hymba_fwd, NWAVES * 64, LDS_BYTES) != hipSuccess || per_cu < 1) { fprintf(stderr, "kernel_launch: occupancy query says %d\n", per_cu); per_cu = 1; }
        (void)hipGetLastError();
        grid = cus;
    }
    if (grid < 0) return;
    (void)hipMemsetAsync((char*)d_ws + WS_CTL, 0, CTL_ZERO_BYTES, stream);
    Args a{};
    for (int i = 0; i < 11; ++i) a.in[i] = (const float*)d_in[i];
    a.out = (float*)d_out; a.ws = (unsigned char*)d_ws;
#if MK_N_LAUNCHES == 1
    a.ph_lo = 0; a.ph_hi = 5;
    void* kargs[] = {&a};
#if USE_CG_SYNC
    hipError_t e = hipLaunchCooperativeKernel((const void*)hymba_fwd, dim3(grid), dim3(NWAVES * 64), kargs, LDS_BYTES, stream);
    if (e != hipSuccess) fprintf(stderr, "kernel_launch: cooperative launch failed: %s (grid %d)\n", hipGetErrorString(e), grid);
#else
    (void)kargs; hipLaunchKernelGGL(hymba_fwd, dim3(grid), dim3(NWAVES * 64), LDS_BYTES, stream, a);
#endif
#else
    for (int ph = 0; ph < 5; ++ph) { a.ph_lo = ph; a.ph_hi = ph + 1; hipLaunchKernelGGL(hymba_fwd, dim3(grid), dim3(NWAVES * 64), LDS_BYTES, stream, a); }
#endif
}
```

```cpp
#include <hip/hip_runtime.h>
#include <hip/hip_cooperative_groups.h>
#include <cstdio>
#include <cstdint>
namespace cg = cooperative_groups;
#ifndef MK_N_LAUNCHES
#define MK_N_LAUNCHES 1
#endif
constexpr int SEQ = 16384, DM = 1024, NCOL_IN = 4104, NPROJ = 4096;
constexpr float LOG2E = 1.4426950408889634f;
constexpr float C2F = 0.125f * 1.4426950408889634f;
constexpr float EPS = 1e-6f;
namespace pg8 {
#define PG8_LAS __attribute__((address_space(3)))
typedef unsigned short bf16_t;
typedef short bf16x8 __attribute__((ext_vector_type(8)));
typedef float f32x4 __attribute__((ext_vector_type(4)));
typedef unsigned u32x4 __attribute__((ext_vector_type(4)));
constexpr int BM = 256, BK = 64, HALF = 128, HTB = HALF * BK * 2  , STAGE_BYTES = 8 * HTB, NXCD = 8, WGM = 8;

__host__ __device__ __forceinline__ int lds_byte(int r, int c) { const int st = (r >> 4) * 2 + (c >> 5), rr = r & 15, cc = c & 31, ob = rr * 64 + cc * 2; return st * 1024 + (ob ^ (((ob >> 9) & 1) << 5)); }
__host__ __device__ __forceinline__ void stage_rc(int b, int& R, int& C) { const int st = b / 1024, sb = b % 1024, swz = sb ^ (((sb >> 9) & 1) << 5); R = (st >> 1) * 16 + swz / 64; C = (st & 1) * 32 + (swz % 64) / 2; }
__host__ __device__ __forceinline__ int perm32(int rho) { const int n = rho >> 4, i = rho & 15; return 8 * (i >> 2) + 4 * n + (i & 3); }

struct Unit { int pm, pn; };
struct Gemm { const bf16_t* A; const bf16_t* Bt; int M, N, K; };

struct StaticOrder {
    int nM, nN, nwg, G, c;
    __host__ __device__ void init(int M, int N, int G_, int c_) { nM = M / BM; nN = N / BM; nwg = nM * nN; G = G_; c = c_; }
    __host__ __device__ bool next(int i, Unit& u) const {
        const long L = (long)i * G + c; if (L >= nwg) return false;
        int wgid = (int)L; { const int q = nwg / NXCD, r = nwg % NXCD, xcd = wgid % NXCD, off = wgid / NXCD; wgid = (xcd < r ? xcd * (q + 1) : r * (q + 1) + (xcd - r) * q) + off; }
        const int nig = WGM * nN, gid = wgid / nig, fm = gid * WGM, gsz = (nM - fm) < WGM ? (nM - fm) : WGM;
        u.pm = fm + ((wgid % nig) % gsz); u.pn = (wgid % nig) / gsz; return true;
    }
    __device__ __forceinline__ void a_ready(const Unit&) const {}
    __device__ __forceinline__ void done(const Unit&) const {}
};


typedef float f32x2 __attribute__((ext_vector_type(2)));
typedef __bf16 bf16x2_t __attribute__((ext_vector_type(2)));
__device__ __forceinline__ unsigned cvt_pk_bf16(float lo, float hi) { f32x2 v = {lo, hi}; bf16x2_t b = __builtin_convertvector(v, bf16x2_t); return __builtin_bit_cast(unsigned, b); }
__device__ __forceinline__ float silu_f(float v) { return v * __builtin_amdgcn_rcpf(1.0f + __builtin_amdgcn_exp2f(-LOG2E * v)); }

struct EpiProj {
    static constexpr bool PERM = true, AFTER_DRAIN = false;
    bf16_t* P; const float* rope; unsigned* kmax;
    template <int MODE  >
    __device__ __forceinline__ void run(const f32x4 (&acc)[2][2][4][2], const Unit& u, int wr, int wc, int fr, int fq) const {
        const int row0 = u.pm * BM + wr * 64 + fr, within = 32 * (wc & 1) + 8 * fq, slot0 = 4 * u.pn + (wc >> 1);
#pragma unroll
        for (int ai = 0; ai < 2; ++ai)
#pragma unroll
            for (int m = 0; m < 4; ++m) {
                const int row = row0 + ai * HALF + m * 16;
                f32x4 c01 = {1.f, 0.f, 1.f, 0.f}, c23 = {1.f, 0.f, 1.f, 0.f};
                if (MODE >= 3) { const f32x4* rp = (const f32x4*)(rope + ((size_t)row * 32 + 16 * (wc & 1) + 4 * fq) * 2); c01 = rp[0]; c23 = rp[1]; }
#pragma unroll
                for (int bj = 0; bj < 2; ++bj) {
                    f32x4 v0 = acc[ai][bj][m][0], v1 = acc[ai][bj][m][1];
                    if (MODE >= 3) {
                        f32x4 r0, r1;
                        r0[0] = v0[0] * c01[0] - v0[1] * c01[1]; r0[1] = v0[1] * c01[0] + v0[0] * c01[1];
                        r0[2] = v0[2] * c01[2] - v0[3] * c01[3]; r0[3] = v0[3] * c01[2] + v0[2] * c01[3];
                        r1[0] = v1[0] * c23[0] - v1[1] * c23[1]; r1[1] = v1[1] * c23[0] + v1[0] * c23[1];
                        r1[2] = v1[2] * c23[2] - v1[3] * c23[3]; r1[3] = v1[3] * c23[2] + v1[2] * c23[3];
                        v0 = r0; v1 = r1;
                    }
                    if (MODE == 1 || MODE == 4) { v0 = v0 * C2F; v1 = v1 * C2F; }
                    if (MODE == 2) { v0[0] = silu_f(v0[0]); v0[1] = silu_f(v0[1]); v0[2] = silu_f(v0[2]); v0[3] = silu_f(v0[3]);
                                     v1[0] = silu_f(v1[0]); v1[1] = silu_f(v1[1]); v1[2] = silu_f(v1[2]); v1[3] = silu_f(v1[3]); }
                    u32x4 w; w.x = cvt_pk_bf16(v0[0], v0[1]); w.y = cvt_pk_bf16(v0[2], v0[3]); w.z = cvt_pk_bf16(v1[0], v1[1]); w.w = cvt_pk_bf16(v1[2], v1[3]);
                    *(u32x4*)(P + ((size_t)(slot0 + 2 * bj) * SEQ + row) * 64 + within) = w;
                }
            }
    }
    __device__ __forceinline__ void operator()(const f32x4 (&acc)[2][2][4][2], const Unit& u, int wr, int wc, int fr, int fq) const {
        const int g = u.pn >> 1;
        if (g == 0) run<1>(acc, u, wr, wc, fr, fq);
        else if (g == 3 || g == 7) run<2>(acc, u, wr, wc, fr, fq);
        else if (g == 4) run<4>(acc, u, wr, wc, fr, fq);
        else if (g == 5) run<3>(acc, u, wr, wc, fr, fq);
        else run<0>(acc, u, wr, wc, fr, fq);
        if (g == 1) {
            const int lane = fr + 16 * fq;
#pragma unroll
            for (int bj = 0; bj < 2; ++bj) { float mx = 0.f;
#pragma unroll
                for (int ai = 0; ai < 2; ++ai)
#pragma unroll
                    for (int m = 0; m < 4; ++m) { const f32x4 v0 = acc[ai][bj][m][0], v1 = acc[ai][bj][m][1];
                        float ss = (v0[0] * v0[0] + v0[1] * v0[1]) + (v0[2] * v0[2] + v0[3] * v0[3]) + (v1[0] * v1[0] + v1[1] * v1[1]) + (v1[2] * v1[2] + v1[3] * v1[3]);
                        ss += __shfl_xor(ss, 16); ss += __shfl_xor(ss, 32); mx = __builtin_fmaxf(mx, ss); }
                mx = __builtin_fmaxf(mx, __shfl_xor(mx, 1)); mx = __builtin_fmaxf(mx, __shfl_xor(mx, 2)); mx = __builtin_fmaxf(mx, __shfl_xor(mx, 4)); mx = __builtin_fmaxf(mx, __shfl_xor(mx, 8));
                if (lane == 0) atomicMax(kmax + (((u.pn - 2) * 4 + 2 * bj + (wc >> 1)) * 2 + (wc & 1)), __float_as_uint(mx)); }
        }
    }
};

struct EpiOut {
    static constexpr bool PERM = false, AFTER_DRAIN = false;
    const float* x; float* out; float* rowss;
    __device__ __forceinline__ void operator()(const f32x4 (&acc)[2][2][4][2], const Unit& u, int wr, int wc, int fr, int fq) const {
        const int col0 = u.pn * BM + wc * 32 + 4 * fq;
#pragma unroll
        for (int ai = 0; ai < 2; ++ai)
#pragma unroll
            for (int m = 0; m < 4; ++m) {
                const int row = u.pm * BM + ai * HALF + wr * 64 + m * 16 + fr; const size_t off = (size_t)row * DM + col0; float ss = 0.f;
#pragma unroll
                for (int bj = 0; bj < 2; ++bj)
#pragma unroll
                    for (int n = 0; n < 2; ++n) { const f32x4 xv = *(const f32x4*)(x + off + bj * HALF + n * 16); const f32x4 h = xv + acc[ai][bj][m][n];
                        *(f32x4*)(out + off + bj * HALF + n * 16) = h; ss += (h[0] * h[0] + h[1] * h[1]) + (h[2] * h[2] + h[3] * h[3]); }
                ss += __shfl_xor(ss, 16); ss += __shfl_xor(ss, 32);
                if (fq == 0) unsafeAtomicAdd(rowss + row, ss);
            }
    }
};

template <class Epi, class Sched, bool ALIGN_EPI = false, bool SP2 = false>
__device__ __forceinline__ void gemm_phase(PG8_LAS unsigned char* lds, const Gemm g, const Sched& S, const Epi& E) {
    const int tid = threadIdx.x, wid = __builtin_amdgcn_readfirstlane(tid >> 6), lane = tid & 63, wr = wid >> 2, wc = wid & 3, fr = lane & 15, fq = lane >> 4;
    const int K = g.K, nt = K / BK;
    unsigned voffA[2], voffB[2];
#pragma unroll
    for (int i = 0; i < 2; ++i) { int R, C; stage_rc(tid * 16 + i * 8192, R, C); const int Rb = Epi::PERM ? ((R & ~31) + perm32(R & 31)) : R;
        voffA[i] = (unsigned)(R * K + C) * 2u; voffB[i] = (unsigned)(Rb * K + C) * 2u; }
    const size_t kstep = (size_t)(BK * 2);
    const size_t hstep = (size_t)HALF * K * 2;
    const size_t tstep = 2 * hstep;
    const unsigned ldsw = (unsigned)wid * 1024u;
    const int aoff = lds_byte(wr * 64 + fr, fq * 8), boff = lds_byte(wc * 32 + fr, fq * 8);
#define PG8_SA(b, h) (((b) * 2 + (h)) * HTB)
#define PG8_SB(b, h) ((4 + (b) * 2 + (h)) * HTB)
#define PG8_STAGE(bufoff, gbase, voff) do { _Pragma("unroll") for (int _i = 0; _i < 2; ++_i) \
        __builtin_amdgcn_global_load_lds((const unsigned*)((const char*)(gbase) + (voff)[_i]), (PG8_LAS unsigned*)(lds + (bufoff) + ldsw + _i * 8192), 16, 0, 0); } while (0)
#define PG8_LDA(dst, b, h) do { _Pragma("unroll") for (int m = 0; m < 4; ++m) _Pragma("unroll") for (int k = 0; k < 2; ++k) dst[m][k] = *(const PG8_LAS bf16x8*)(lds + PG8_SA(b, h) + aoff + m * 2048 + k * 1024); } while (0)
#define PG8_LDB(dst, b, h) do { _Pragma("unroll") for (int n = 0; n < 2; ++n) _Pragma("unroll") for (int k = 0; k < 2; ++k) dst[n][k] = *(const PG8_LAS bf16x8*)(lds + PG8_SB(b, h) + boff + n * 2048 + k * 1024); } while (0)
#define PG8_MMA(ai, bj, At, Bt) do { __builtin_amdgcn_s_setprio(1); _Pragma("unroll") for (int m = 0; m < 4; ++m) _Pragma("unroll") for (int n = 0; n < 2; ++n) _Pragma("unroll") for (int k = 0; k < 2; ++k) \
        acc[ai][bj][m][n] = __builtin_amdgcn_mfma_f32_16x16x32_bf16(Bt[n][k], At[m][k], acc[ai][bj][m][n], 0, 0, 0); __builtin_amdgcn_s_setprio(0); } while (0)
#define PG8_WAIT_V(n) asm volatile("s_waitcnt vmcnt(" #n ")" ::: "memory")
#define PG8_WAIT_L(n) asm volatile("s_waitcnt lgkmcnt(" #n ")" ::: "memory")
#define PG8_BAR __builtin_amdgcn_s_barrier()
#define PG8_SCHED __builtin_amdgcn_sched_barrier(0)
    Unit cur, nxt; int ui = 0;
    if (!S.next(0, cur)) return;
    f32x4 acc[2][2][4][2];
#pragma unroll
    for (int a = 0; a < 2; ++a)
#pragma unroll
        for (int b = 0; b < 2; ++b)
#pragma unroll
            for (int m = 0; m < 4; ++m)
#pragma unroll
                for (int n = 0; n < 2; ++n) acc[a][b][m][n] = (f32x4){0.f, 0.f, 0.f, 0.f};
    bf16x8 At[4][2], B0[2][2], B1[2][2];
    const char* cA = (const char*)g.A + (size_t)cur.pm * tstep; const char* cB = (const char*)g.Bt + (size_t)cur.pn * tstep;
    S.a_ready(cur);
    if constexpr (SP2) {
        PG8_STAGE(PG8_SB(0, 0), cB, voffB); PG8_STAGE(PG8_SB(0, 1), cB + hstep, voffB); PG8_STAGE(PG8_SA(0, 0), cA, voffA); PG8_STAGE(PG8_SA(0, 1), cA + hstep, voffA);
        if (wr == 1) PG8_BAR;
        PG8_WAIT_V(2); PG8_BAR;
        PG8_STAGE(PG8_SB(1, 0), cB + kstep, voffB); PG8_STAGE(PG8_SA(1, 0), cA + kstep, voffA); PG8_STAGE(PG8_SB(1, 1), cB + hstep + kstep, voffB);
        PG8_WAIT_V(6); PG8_BAR;
    } else {
        PG8_STAGE(PG8_SB(0, 0), cB, voffB); PG8_STAGE(PG8_SA(0, 0), cA, voffA); PG8_STAGE(PG8_SB(0, 1), cB + hstep, voffB); PG8_STAGE(PG8_SA(0, 1), cA + hstep, voffA);
        if (wr == 1) PG8_BAR;
        PG8_WAIT_V(4); PG8_BAR;
        PG8_STAGE(PG8_SB(1, 0), cB + kstep, voffB); PG8_STAGE(PG8_SA(1, 0), cA + kstep, voffA); PG8_STAGE(PG8_SB(1, 1), cB + hstep + kstep, voffB);
        PG8_WAIT_V(6); PG8_BAR;
    }
    for (;;) {
        const bool has_next = S.next(ui + 1, nxt);
        const char* nA = has_next ? (const char*)g.A + (size_t)nxt.pm * tstep : cA; const char* nB = has_next ? (const char*)g.Bt + (size_t)nxt.pn * tstep : cB;
        for (int t = 0; t < nt; t += 2) {
            const bool last = (t == nt - 2);
            const char* a1 = cA + (size_t)(t + 1) * kstep;
            const char* a2 = last ? nA : cA + (size_t)(t + 2) * kstep; const char* b2 = last ? nB : cB + (size_t)(t + 2) * kstep;
            const char* a3 = a2 + kstep; const char* b3 = b2 + kstep;
            if (last && has_next) S.a_ready(nxt);
            if constexpr (SP2) {
            PG8_LDB(B0, 0, 0); PG8_LDB(B1, 0, 1); PG8_SCHED; PG8_LDA(At, 0, 0); PG8_STAGE(PG8_SA(1, 1), a1 + hstep, voffA);
            PG8_WAIT_V(8); PG8_WAIT_L(0); PG8_BAR; PG8_MMA(0, 0, At, B0); PG8_MMA(0, 1, At, B1); PG8_BAR; PG8_SCHED;
            PG8_LDA(At, 0, 1); PG8_STAGE(PG8_SB(0, 0), b2, voffB); PG8_STAGE(PG8_SB(0, 1), b2 + hstep, voffB); PG8_STAGE(PG8_SA(0, 0), a2, voffA);
            PG8_WAIT_V(8); PG8_WAIT_L(0); PG8_BAR; PG8_MMA(1, 0, At, B0); PG8_MMA(1, 1, At, B1); PG8_BAR; PG8_SCHED;
            PG8_LDB(B0, 1, 0); PG8_LDB(B1, 1, 1); PG8_SCHED; PG8_LDA(At, 1, 0); PG8_STAGE(PG8_SA(0, 1), a2 + hstep, voffA);
            PG8_WAIT_V(8); PG8_WAIT_L(0); PG8_BAR; PG8_MMA(0, 0, At, B0); PG8_MMA(0, 1, At, B1); PG8_BAR; PG8_SCHED;
            PG8_LDA(At, 1, 1); PG8_STAGE(PG8_SB(1, 0), b3, voffB); PG8_STAGE(PG8_SB(1, 1), b3 + hstep, voffB); PG8_STAGE(PG8_SA(1, 0), a3, voffA);
            PG8_WAIT_V(8); PG8_WAIT_L(0); PG8_BAR; PG8_MMA(1, 0, At, B0); PG8_MMA(1, 1, At, B1); PG8_BAR; PG8_SCHED;
            } else {
            PG8_LDB(B0, 0, 0); PG8_SCHED; PG8_LDA(At, 0, 0); PG8_STAGE(PG8_SA(1, 1), a1 + hstep, voffA);
            PG8_WAIT_L(8); PG8_BAR; PG8_WAIT_L(0); PG8_MMA(0, 0, At, B0); PG8_BAR; PG8_SCHED;
            PG8_LDB(B1, 0, 1); PG8_STAGE(PG8_SB(0, 0), b2, voffB);
            PG8_BAR; PG8_WAIT_L(0); PG8_MMA(0, 1, At, B1); PG8_BAR;
            PG8_LDA(At, 0, 1); PG8_STAGE(PG8_SA(0, 0), a2, voffA);
            PG8_BAR; PG8_WAIT_L(0); PG8_MMA(1, 0, At, B0); PG8_BAR; PG8_SCHED;
            PG8_STAGE(PG8_SB(0, 1), b2 + hstep, voffB);
            PG8_WAIT_V(6); PG8_BAR; PG8_MMA(1, 1, At, B1); PG8_BAR;
            PG8_LDB(B0, 1, 0); PG8_SCHED; PG8_LDA(At, 1, 0); PG8_STAGE(PG8_SA(0, 1), a2 + hstep, voffA);
            PG8_WAIT_L(8); PG8_BAR; PG8_WAIT_L(0); PG8_MMA(0, 0, At, B0); PG8_BAR; PG8_SCHED;
            PG8_LDB(B1, 1, 1); PG8_STAGE(PG8_SB(1, 0), b3, voffB);
            PG8_BAR; PG8_WAIT_L(0); PG8_MMA(0, 1, At, B1); PG8_BAR;
            PG8_LDA(At, 1, 1); PG8_STAGE(PG8_SA(1, 0), a3, voffA);
            PG8_BAR; PG8_WAIT_L(0); PG8_MMA(1, 0, At, B0); PG8_BAR; PG8_SCHED;
            PG8_STAGE(PG8_SB(1, 1), b3 + hstep, voffB);
            PG8_WAIT_V(6); PG8_BAR; PG8_MMA(1, 1, At, B1); PG8_BAR;
            }
        }
        if constexpr (ALIGN_EPI) { if (wr == 0) PG8_BAR; }
        if constexpr (!Epi::AFTER_DRAIN) { E(acc, cur, wr, wc, fr, fq); S.done(cur); }
        if (!has_next) break;
#pragma unroll
        for (int a = 0; a < 2; ++a)
#pragma unroll
            for (int b = 0; b < 2; ++b)
#pragma unroll
                for (int m = 0; m < 4; ++m)
#pragma unroll
                    for (int n = 0; n < 2; ++n) acc[a][b][m][n] = (f32x4){0.f, 0.f, 0.f, 0.f};
        cur = nxt; cA = nA; cB = nB; ++ui;
        if constexpr (ALIGN_EPI) { if (wr == 1) PG8_BAR; }
    }
    PG8_WAIT_V(0);
    if constexpr (!ALIGN_EPI) { if (wr == 0) PG8_BAR; }
    PG8_BAR;
    if constexpr (Epi::AFTER_DRAIN) { E.fused(acc, cur, wr, wc, fr, fq, lds, wid, lane); S.done(cur); }
#undef PG8_SA
#undef PG8_SB
#undef PG8_STAGE
#undef PG8_LDA
#undef PG8_LDB
#undef PG8_MMA
#undef PG8_WAIT_V
#undef PG8_WAIT_L
#undef PG8_BAR
#undef PG8_SCHED
}
}

namespace att {
#define LAS __attribute__((address_space(3)))
typedef unsigned short bf16_t;
typedef short bf16x8 __attribute__((ext_vector_type(8)));
typedef short s16x4 __attribute__((ext_vector_type(4)));
typedef short v4i16_t __attribute__((ext_vector_type(4)));
typedef float f32x16 __attribute__((ext_vector_type(16)));
typedef float f32x4 __attribute__((ext_vector_type(4)));
typedef float f32x2 __attribute__((ext_vector_type(2)));
typedef unsigned u32x4 __attribute__((ext_vector_type(4)));
typedef __bf16 bf16x2_t __attribute__((ext_vector_type(2)));
constexpr int K_OFF = 0, V_OFF = 16384, G_OFF = 49152, FLAG_OFF = 49664, WSF_OFF = 50176, OST_OFF = 53248, ATT_BYTES = OST_OFF + 8 * 8192;
constexpr float THR = 8.0f;
__device__ __forceinline__ int crow(int r, int hi) { return (r & 3) + 8 * (r >> 2) + 4 * hi; }
__device__ __forceinline__ unsigned cvtpk(float lo, float hi) { f32x2 v = {lo, hi}; bf16x2_t b = __builtin_convertvector(v, bf16x2_t); return __builtin_bit_cast(unsigned, b); }
__device__ __forceinline__ void glds16(const void* g, unsigned lds_dst) { unsigned keep;
    asm volatile("s_mov_b32 %0, m0\n\ts_mov_b32 m0, %2\n\ts_nop 0\n\tglobal_load_lds_dwordx4 %1, off\n\ts_mov_b32 m0, %0" : "=&s"(keep) : "v"(g), "s"(lds_dst) : "memory"); }
__device__ __forceinline__ void glds4(const void* g, unsigned lds_dst) { unsigned keep;
    asm volatile("s_mov_b32 %0, m0\n\ts_mov_b32 m0, %2\n\ts_nop 0\n\tglobal_load_lds_dword %1, off\n\ts_mov_b32 m0, %0" : "=&s"(keep) : "v"(g), "s"(lds_dst) : "memory"); }
#define ATT_WAIT_BAR0() asm volatile("s_waitcnt vmcnt(0) lgkmcnt(0)\n\ts_barrier" ::: "memory")
#define ATT_MFMA(a, b, c) __builtin_amdgcn_mfma_f32_32x32x16_bf16(a, b, c, 0, 0, 0)
__device__ __forceinline__ s16x4 vtr(LAS const unsigned char* p) { return __builtin_bit_cast(s16x4, __builtin_amdgcn_ds_read_tr16_b64_v4i16((LAS v4i16_t*)p)); }
__device__ __forceinline__ float rowmax32(const f32x16& p0, const f32x16& p1) {
    float a = __builtin_fmaxf(p0[0], p1[0]);
#pragma unroll
    for (int r = 1; r < 16; ++r) a = __builtin_fmaxf(__builtin_fmaxf(a, p0[r]), p1[r]);
    auto rr = __builtin_amdgcn_permlane32_swap(__float_as_uint(a), __float_as_uint(a), false, false);
    return __builtin_fmaxf(__uint_as_float(rr[0]), __uint_as_float(rr[1]));
}
__device__ __forceinline__ float halfsum(float v) {
    auto rr = __builtin_amdgcn_permlane32_swap(__float_as_uint(v), __float_as_uint(v), false, false);
    return __uint_as_float(rr[0]) + __uint_as_float(rr[1]);
}

template <int DV, bool FOX>
__device__ __forceinline__ void attn_pass(LAS unsigned char* lds, const bf16_t* __restrict__ Qh, const bf16_t* __restrict__ Kh, const bf16_t* __restrict__ Va, const bf16_t* __restrict__ Vb,
                                          const float* __restrict__ Gh, const unsigned* __restrict__ kmx, int qb, f32x16 (&o)[DV / 32], float& l_out) {
    const int tid = threadIdx.x, lane = tid & 63, r32 = lane & 31, hi = lane >> 5;
    const int w = __builtin_amdgcn_readfirstlane(tid >> 6);
    const int q0 = qb * 256, NTu = 4 * qb + 4, my_nt = 4 * qb + (w >> 1) + 1;
    const unsigned lds0 = (unsigned)(uintptr_t)lds;
    LAS float* wsf = (LAS float*)(lds + WSF_OFF) + w * 64;
    const bf16_t* ksrc = Kh + (size_t)lane * 64 + w * 8;
    const size_t voff = (size_t)(16 * (w & 3) + (lane >> 2)) * 64 + (w >> 2) * 32 + (lane & 3) * 8;
    const bf16_t* vsrcA = Va + voff; const bf16_t* vsrcB = (DV == 128) ? Vb + voff : Va;
    const unsigned kdst = lds0 + K_OFF + w * 1024, vdstA = lds0 + V_OFF + w * 1024, vdstB = lds0 + V_OFF + (w + 8) * 1024, gdst = lds0 + G_OFF;
#define ATT_DMA(t, sl) do { const size_t to_ = (size_t)(t) * 4096; \
        glds16(ksrc + to_, (unsigned)__builtin_amdgcn_readfirstlane(kdst + (sl) * 8192)); \
        glds16(vsrcA + to_, (unsigned)__builtin_amdgcn_readfirstlane(vdstA + (sl) * 16384)); \
        if (DV == 128) glds16(vsrcB + to_, (unsigned)__builtin_amdgcn_readfirstlane(vdstB + (sl) * 16384)); \
        if (FOX) { if (w == 0) glds4(Gh + (size_t)(t) * 64 + lane, (unsigned)__builtin_amdgcn_readfirstlane(gdst + (sl) * 256)); } } while (0)
    ATT_DMA(FOX ? NTu - 1 : 0, 0);
    bf16x8 qr[4];
    { const bf16_t* Qw = Qh + (size_t)(q0 + 32 * w + r32) * 64 + hi * 8;
#pragma unroll
      for (int d0 = 0; d0 < 4; ++d0) qr[d0] = *(const bf16x8*)(Qw + d0 * 16); }
    const float gq = FOX ? Gh[q0 + 32 * w + r32] : 0.f;
    float bq = 0.f;
    if (FOX) { float n1 = 0.f, n2 = 0.f;
#pragma unroll
        for (int e = 0; e < 8; ++e) { const float a0 = __uint_as_float((unsigned)(unsigned short)qr[0][e] << 16), a1 = __uint_as_float((unsigned)(unsigned short)qr[1][e] << 16),
                                                  a2 = __uint_as_float((unsigned)(unsigned short)qr[2][e] << 16), a3 = __uint_as_float((unsigned)(unsigned short)qr[3][e] << 16);
            n1 += a0 * a0 + a1 * a1; n2 += a2 * a2 + a3 * a3; }
        n1 = halfsum(n1); n2 = halfsum(n2);
        const unsigned k1 = __hip_atomic_load(kmx, __ATOMIC_RELAXED, __HIP_MEMORY_SCOPE_AGENT), k2 = __hip_atomic_load(kmx + 1, __ATOMIC_RELAXED, __HIP_MEMORY_SCOPE_AGENT);
        bq = 1.01f * (sqrtf(n1) * sqrtf(__uint_as_float(k1)) + sqrtf(n2) * sqrtf(__uint_as_float(k2))); }
    float cref = gq;
    f32x16 cinit;
#pragma unroll
    for (int r = 0; r < 16; ++r) cinit[r] = gq;
    float l = 0.f;
#pragma unroll
    for (int d = 0; d < DV / 32; ++d)
#pragma unroll
        for (int r = 0; r < 16; ++r) o[d][r] = 0.f;
    bool first = true;
    for (int i = 0; i < NTu; ++i) {
        ATT_WAIT_BAR0();
        const int t = FOX ? NTu - 1 - i : i, sl = i & 1;
        if (FOX && i > 0) {
            const u32x4 fa = *(LAS const u32x4*)(lds + FLAG_OFF + (sl ^ 1) * 32), fb = *(LAS const u32x4*)(lds + FLAG_OFF + (sl ^ 1) * 32 + 16);
            const unsigned all_ = (fa.x & fa.y) & (fa.z & fa.w) & (fb.x & fb.y) & (fb.z & fb.w);
            if (__builtin_amdgcn_readfirstlane(all_) != 0u) break;
        }
        unsigned done_w = 0u;
        if (i + 1 < NTu) ATT_DMA(FOX ? t - 1 : t + 1, sl ^ 1);
        if (t < my_nt) {
            LAS const unsigned char* kp = lds + K_OFF + sl * 8192 + hi * 1024 + r32 * 16;
            f32x16 p0, p1;
#pragma unroll
            for (int d0 = 0; d0 < 4; ++d0) {
                const bf16x8 b0 = *(LAS const bf16x8*)(kp + d0 * 2048), b1 = *(LAS const bf16x8*)(kp + d0 * 2048 + 512);
                if (d0 == 0) { p0 = ATT_MFMA(b0, qr[0], cinit); p1 = ATT_MFMA(b1, qr[0], cinit); }
                else { p0 = ATT_MFMA(b0, qr[d0], p0); p1 = ATT_MFMA(b1, qr[d0], p1); }
            }
            if (FOX) {
                LAS const float* gp = (LAS const float*)(lds + G_OFF + sl * 256) + 4 * hi;
#pragma unroll
                for (int g = 0; g < 4; ++g) { const f32x4 a = *(LAS const f32x4*)(gp + 8 * g), b = *(LAS const f32x4*)(gp + 32 + 8 * g);
#pragma unroll
                    for (int e = 0; e < 4; ++e) { p0[4 * g + e] -= a[e]; p1[4 * g + e] -= b[e]; } }
                if (t == my_nt - 1) {
                    const int lim = 32 * (w & 1) + r32;
#pragma unroll
                    for (int r = 0; r < 16; ++r) { const int kk = crow(r, hi); if (kk > lim) p0[r] = -INFINITY; if (kk + 32 > lim) p1[r] = -INFINITY; }
                }
            }
            const float rm = rowmax32(p0, p1);
            if (first || __any(rm > THR)) {
                const float dl = first ? rm : __builtin_fmaxf(rm, 0.f);
                p0 = p0 - dl; p1 = p1 - dl; cinit = cinit - dl; cref -= dl;
                if (!first) {
                    const float f = __builtin_amdgcn_exp2f(-dl); l *= f;
                    if (hi == 0) wsf[r32] = f;
                    __builtin_amdgcn_fence(__ATOMIC_RELEASE, "wavefront");
#pragma unroll
                    for (int r = 0; r < 16; ++r) { const float fr_ = wsf[crow(r, hi)];
#pragma unroll
                        for (int d = 0; d < DV / 32; ++d) o[d][r] *= fr_; }
                }
                first = false;
            }
            float sacc = 0.f;
#pragma unroll
            for (int r = 0; r < 16; ++r) { p0[r] = __builtin_amdgcn_exp2f(p0[r]); p1[r] = __builtin_amdgcn_exp2f(p1[r]); sacc += p0[r] + p1[r]; }
            l += sacc;
            u32x4 pw[4];
#pragma unroll
            for (int s = 0; s < 2; ++s) {
                pw[s]     = (u32x4){cvtpk(p0[8 * s], p0[8 * s + 1]), cvtpk(p0[8 * s + 2], p0[8 * s + 3]), cvtpk(p0[8 * s + 4], p0[8 * s + 5]), cvtpk(p0[8 * s + 6], p0[8 * s + 7])};
                pw[2 + s] = (u32x4){cvtpk(p1[8 * s], p1[8 * s + 1]), cvtpk(p1[8 * s + 2], p1[8 * s + 3]), cvtpk(p1[8 * s + 4], p1[8 * s + 5]), cvtpk(p1[8 * s + 6], p1[8 * s + 7])};
            }
            LAS const unsigned char* vp = lds + V_OFF + sl * 16384 + ((lane >> 4) & 1) * 32 + (lane & 3) * 8 + (4 * hi + ((lane & 15) >> 2)) * 64;
#pragma unroll
            for (int d = 0; d < DV / 32; ++d)
#pragma unroll
                for (int s = 0; s < 4; ++s) {
                    const s16x4 lo = vtr(vp + d * 4096 + s * 1024), hh = vtr(vp + d * 4096 + s * 1024 + 512);
                    const bf16x8 vf = (bf16x8){lo[0], lo[1], lo[2], lo[3], hh[0], hh[1], hh[2], hh[3]};
                    o[d] = ATT_MFMA(__builtin_bit_cast(bf16x8, pw[s]), vf, o[d]);
                }
            if (FOX) {
                const float gt0 = *(LAS const float*)(lds + G_OFF + sl * 256);
                done_w = __all((bq - gt0) + cref + 160.0f < 0.f) ? 1u : 0u;
            }
        }
        if (FOX) { if (lane == 0) *(LAS unsigned*)(lds + FLAG_OFF + sl * 32 + w * 4) = done_w; }
    }
    ATT_WAIT_BAR0();
    l_out = halfsum(l);
#undef ATT_DMA
}

__device__ __forceinline__ void row_recip(LAS float* wsf, float l, int r32, int hi, float (&rli)[16]) {
    if (hi == 0) wsf[32 + r32] = l;
    __builtin_amdgcn_fence(__ATOMIC_RELEASE, "wavefront");
#pragma unroll
    for (int r = 0; r < 16; ++r) rli[r] = __builtin_amdgcn_rcpf(wsf[32 + crow(r, hi)]);
}
__device__ __forceinline__ void stage_gate_store(LAS float* stg, const f32x16& a0, const f32x16& a1, int lane, int r32, int hi,
                                                 const bf16_t* __restrict__ gate  , bf16_t* __restrict__ outp  ) {
#pragma unroll
    for (int r = 0; r < 16; ++r) { const int orow = crow(r, hi); stg[orow * 64 + r32] = a0[r]; stg[orow * 64 + 32 + r32] = a1[r]; }
    __builtin_amdgcn_fence(__ATOMIC_RELEASE, "wavefront");
#pragma unroll
    for (int i = 0; i < 4; ++i) {
        const int row = i * 8 + (lane >> 3), ch = lane & 7;
        const f32x4 x0 = *(LAS const f32x4*)(stg + row * 64 + ch * 8), x1 = *(LAS const f32x4*)(stg + row * 64 + ch * 8 + 4);
        const u32x4 gv = *(const u32x4*)(gate + (size_t)row * 64 + ch * 8);
        u32x4 ov;
        ov.x = cvtpk(x0[0] * __uint_as_float(gv.x << 16), x0[1] * __uint_as_float(gv.x & 0xffff0000u));
        ov.y = cvtpk(x0[2] * __uint_as_float(gv.y << 16), x0[3] * __uint_as_float(gv.y & 0xffff0000u));
        ov.z = cvtpk(x1[0] * __uint_as_float(gv.z << 16), x1[1] * __uint_as_float(gv.z & 0xffff0000u));
        ov.w = cvtpk(x1[2] * __uint_as_float(gv.w << 16), x1[3] * __uint_as_float(gv.w & 0xffff0000u));
        *(u32x4*)(outp + (size_t)row * DM + ch * 8) = ov;
    }
    __builtin_amdgcn_fence(__ATOMIC_RELEASE, "wavefront");
}

__device__ __forceinline__ const bf16_t* slot_ptr(const bf16_t* P, int s) { return P + (size_t)s * SEQ * 64; }

__device__ __forceinline__ void fox_unit(LAS unsigned char* lds, const bf16_t* P, const float* G, const unsigned* kmax, bf16_t* MIXED, int h, int qb) {
    const int tid = threadIdx.x, lane = tid & 63, r32 = lane & 31, hi = lane >> 5; const int w = __builtin_amdgcn_readfirstlane(tid >> 6);
    f32x16 o[2]; float l;
    attn_pass<64, true>(lds, slot_ptr(P, h), slot_ptr(P, 8 + h), slot_ptr(P, 16 + h), nullptr, G + (size_t)h * SEQ, kmax + 2 * h, qb, o, l);
    LAS float* wsf = (LAS float*)(lds + WSF_OFF) + w * 64; float rli[16];
    row_recip(wsf, l, r32, hi, rli);
#pragma unroll
    for (int r = 0; r < 16; ++r) { o[0][r] *= rli[r]; o[1][r] *= rli[r]; }
    const int row0 = qb * 256 + 32 * w;
    stage_gate_store((LAS float*)(lds + OST_OFF + w * 8192), o[0], o[1], lane, r32, hi, slot_ptr(P, 24 + h) + (size_t)row0 * 64, MIXED + (size_t)row0 * DM + h * 64);
}

constexpr size_t OBUF_MAP_FLOATS = (size_t)4 * 64 * 8 * 64 * 64;
__device__ __forceinline__ void diff_unit(LAS unsigned char* lds, volatile LAS int* misc, const bf16_t* P, bf16_t* MIXED, float* obuf, unsigned* tick, float lam, const float* __restrict__ subln_g, int mp, int qb) {
    const int tid = threadIdx.x, lane = tid & 63, r32 = lane & 31, hi = lane >> 5; const int w = __builtin_amdgcn_readfirstlane(tid >> 6);
    const int hd = mp >> 1, m = mp & 1;
    LAS float* wsf = (LAS float*)(lds + WSF_OFF) + w * 64; float rli[16];
    f32x16 o[4]; float l;
    attn_pass<128, false>(lds, slot_ptr(P, 32 + mp), slot_ptr(P, 40 + mp), slot_ptr(P, 48 + 2 * hd), slot_ptr(P, 49 + 2 * hd), nullptr, nullptr, qb, o, l);
    row_recip(wsf, l, r32, hi, rli);
    const size_t rec = (((size_t)(hd * 64 + qb) * 8 + w) * 64 + lane) * 64;
    f32x4* mine = (f32x4*)(obuf + (size_t)m * OBUF_MAP_FLOATS + rec);
    const f32x4* other = (const f32x4*)(obuf + (size_t)(m ^ 1) * OBUF_MAP_FLOATS + rec);
#pragma unroll
    for (int d = 0; d < 4; ++d)
#pragma unroll
        for (int r = 0; r < 16; ++r) o[d][r] *= rli[r];
#pragma unroll
    for (int d = 0; d < 4; ++d)
#pragma unroll
        for (int r4 = 0; r4 < 4; ++r4) mine[d * 4 + r4] = (f32x4){o[d][4 * r4], o[d][4 * r4 + 1], o[d][4 * r4 + 2], o[d][4 * r4 + 3]};
    asm volatile("s_waitcnt vmcnt(0)" ::: "memory");
    __syncthreads();
    if (tid == 0) { __builtin_amdgcn_fence(__ATOMIC_RELEASE, "agent"); asm volatile("s_waitcnt vmcnt(0)" ::: "memory");
                    misc[1] = (int)__hip_atomic_fetch_add(tick + hd * 64 + qb, 1u, __ATOMIC_RELAXED, __HIP_MEMORY_SCOPE_AGENT); }
    __syncthreads();
    if (misc[1] == 0) return;
    if (tid == 0) { __builtin_amdgcn_fence(__ATOMIC_ACQUIRE, "agent"); asm volatile("s_waitcnt vmcnt(0)" ::: "memory"); }
    __syncthreads();
    const float ca = (m == 0) ? 1.0f : -lam, cb = (m == 0) ? -lam : 1.0f;
    float ss[16];
#pragma unroll
    for (int r = 0; r < 16; ++r) ss[r] = 0.f;
#pragma unroll
    for (int d = 0; d < 4; ++d) {
#pragma unroll
        for (int r4 = 0; r4 < 4; ++r4) { const f32x4 sv = other[d * 4 + r4];
#pragma unroll
            for (int e = 0; e < 4; ++e) { const int r = 4 * r4 + e; const float v = ca * o[d][r] + cb * sv[e]; o[d][r] = v; ss[r] += v * v; } }
        asm volatile("" ::: "memory");
    }
#pragma unroll
    for (int r = 0; r < 16; ++r) { float s_ = ss[r]; s_ += __shfl_xor(s_, 1); s_ += __shfl_xor(s_, 2); s_ += __shfl_xor(s_, 4); s_ += __shfl_xor(s_, 8); s_ += __shfl_xor(s_, 16);
        ss[r] = __builtin_amdgcn_rsqf(s_ * (1.0f / 128.0f) + EPS) * 0.8f; }
#pragma unroll
    for (int d = 0; d < 4; ++d) { const float gs = subln_g[32 * d + r32];
#pragma unroll
        for (int r = 0; r < 16; ++r) o[d][r] *= ss[r] * gs; }
    const int row0 = qb * 256 + 32 * w;
    LAS float* stg = (LAS float*)(lds + OST_OFF + w * 8192);
    stage_gate_store(stg, o[0], o[1], lane, r32, hi, slot_ptr(P, 56 + 2 * hd) + (size_t)row0 * 64, MIXED + (size_t)row0 * DM + 512 + hd * 128);
    stage_gate_store(stg, o[2], o[3], lane, r32, hi, slot_ptr(P, 57 + 2 * hd) + (size_t)row0 * 64, MIXED + (size_t)row0 * DM + 512 + hd * 128 + 64);
}
#undef LAS
}
#define LAS __attribute__((address_space(3)))
#define XB_TMO      128
#define XB_XCNT(j)  (256  + 64 * (j))
#define XB_XSUB(j)  (1280 + 64 * (j))
#define XB_XGEN(j)  (2304 + 64 * (j))
#define XB_TOP      3328
#define XB_TOPGEN   3392
#define XCD_BAR_WORDS 3456
#define XB_SPIN_CAP (1u << 18)

__device__ __forceinline__ unsigned xb_ld(unsigned* p)              { return __hip_atomic_load(p, __ATOMIC_RELAXED, __HIP_MEMORY_SCOPE_AGENT); }
__device__ __forceinline__ unsigned xb_add(unsigned* p, unsigned v) { return __hip_atomic_fetch_add(p, v, __ATOMIC_RELAXED, __HIP_MEMORY_SCOPE_AGENT); }
__device__ __forceinline__ unsigned xb_xcc_id() { return (unsigned)__builtin_amdgcn_s_getreg((3 << 11) | 20) & 0xFu; }
#define XB_SPIN(cond, bar) do { unsigned _sp = 0; while (cond) { __builtin_amdgcn_s_sleep(1); \
    if ((++_sp & 255u) == 0u) { if (xb_ld(&(bar)[XB_TMO])) break; if (_sp > XB_SPIN_CAP) { atomicAdd(&(bar)[XB_TMO], 1u); break; } } } } while (0)

struct XcdBarrier {
    unsigned* bar; unsigned x;
    volatile LAS unsigned* st;
};

__device__ __forceinline__ XcdBarrier xcd_barrier_post(unsigned* bar, volatile LAS unsigned* st) {
    XcdBarrier b; b.bar = bar; b.x = xb_xcc_id(); b.st = st;
    if (threadIdx.x == 0) (void)xb_add(&bar[XB_XCNT(b.x)], 1u);
    return b;
}
__device__ __forceinline__ void xcd_barrier_complete(unsigned* bar, unsigned x, unsigned& nloc, unsigned& nx) {
    const unsigned G = gridDim.x * gridDim.y * gridDim.z;
    unsigned sum, cnt, mine, sp = 0u;
    for (;;) {
        sum = 0u; cnt = 0u; mine = 0u;
#pragma unroll
        for (unsigned j = 0; j < 16; ++j) { const unsigned c = xb_ld(&bar[XB_XCNT(j)]); sum += c; cnt += (c > 0u) ? 1u : 0u; mine = (j == x) ? c : mine; }
        if (sum == G) break;
        __builtin_amdgcn_s_sleep(1);
        if ((++sp & 255u) == 0u) { if (xb_ld(&bar[XB_TMO])) break; if (sp > XB_SPIN_CAP) { atomicAdd(&bar[XB_TMO], 1u); break; } }
    }
    nloc = mine > 0u ? mine : 1u; nx = cnt > 0u ? cnt : 1u;
}

__device__ __forceinline__ void xcd_barrier(const XcdBarrier& b) {
    asm volatile("s_waitcnt vmcnt(0)" ::: "memory");
    __syncthreads();
    if (threadIdx.x == 0) {
        unsigned* bar = b.bar;
        __builtin_amdgcn_s_waitcnt(0);
        unsigned nloc = b.st[0], nx = b.st[1];
        if (nloc == 0u) { xcd_barrier_complete(bar, b.x, nloc, nx); b.st[0] = nloc; b.st[1] = nx; }
        const unsigned old = xb_add(&bar[XB_XSUB(b.x)], 1u);
        const unsigned gen = old / nloc;
        if (old + 1u == (gen + 1u) * nloc) {
            __builtin_amdgcn_fence(__ATOMIC_RELEASE, "agent");
            asm volatile("s_waitcnt vmcnt(0)" ::: "memory");
            const unsigned og = xb_add(&bar[XB_TOP], 1u);
            const unsigned tg = og / nx;
            if (og + 1u == (tg + 1u) * nx) xb_add(&bar[XB_TOPGEN], 1u);
            else XB_SPIN(xb_ld(&bar[XB_TOPGEN]) == tg, bar);
            __builtin_amdgcn_fence(__ATOMIC_ACQUIRE, "agent");
            xb_add(&bar[XB_XGEN(b.x)], 1u);
            asm volatile("s_waitcnt vmcnt(0)" ::: "memory");
        } else {
            XB_SPIN(xb_ld(&bar[XB_XGEN(b.x)]) == gen, bar);
            __builtin_amdgcn_fence(__ATOMIC_ACQUIRE, "agent");
            asm volatile("s_waitcnt vmcnt(0)" ::: "memory");
        }
    }
    __syncthreads();
}
#undef LAS

#define LAS __attribute__((address_space(3)))
typedef unsigned short bf16;
typedef float f32x4 __attribute__((ext_vector_type(4)));
typedef unsigned v4u __attribute__((ext_vector_type(4)));
constexpr int NWAVES = 8;
constexpr size_t MiB = 1u << 20;
constexpr size_t WS_CTL = 0, CTL_ZERO_BYTES = 1 * MiB;
constexpr size_t WS_WIN = 1 * MiB;
constexpr size_t WS_WOUT = 9 * MiB;
constexpr size_t WS_ROPE = 11 * MiB;
constexpr size_t WS_LOGF = 15 * MiB;
constexpr size_t WS_G = 15 * MiB + 512 * 1024;
constexpr size_t WS_U = 16 * MiB;
constexpr size_t WS_PROJ = 48 * MiB;
constexpr size_t WS_STASH = 176 * MiB;
constexpr size_t WS_END = 240 * MiB;
constexpr int CW_QUEUE = 0, CW_KMAX = 64, CW_TICK = 128, CW_BAR = 4096;
#ifndef USE_CG_SYNC
#define USE_CG_SYNC 0
#endif
constexpr size_t CTL_ROWSS = 65536;
constexpr int RING_BYTES = 131072, MISC_OFF = RING_BYTES, LDS_BYTES = 147456;
static_assert(att::ATT_BYTES <= RING_BYTES, "attention LDS map");

__device__ __forceinline__ unsigned f2bf(float f) { unsigned u = __builtin_bit_cast(unsigned, f); return (u + 0x7fffu + ((u >> 16) & 1u)) >> 16; }
__device__ __forceinline__ unsigned pk2(float lo, float hi) { return f2bf(lo) | (f2bf(hi) << 16); }
__device__ __forceinline__ float wave_sum(float v) {
#pragma unroll
    for (int o = 1; o < 64; o <<= 1) v += __shfl_xor(v, o);
    return v;
}
__device__ __forceinline__ int orig_col(int n) {
    const int g = n >> 9, wi = n & 511; const int base = g * 512 + (g >= 4 ? 8 : 0);
    if (g == 4 || g == 5) { const int head = wi >> 6, j = wi & 63; return base + head * 64 + (j >> 1) + 32 * (j & 1); }
    return base + wi;
}
__device__ __forceinline__ void transpose_item(const float* __restrict__ W, int ldw, int K, bf16* __restrict__ WT, LAS float* scr, int item, int nblk, int lane, bool permuted) {
    const int kb = item / nblk, nb = item % nblk, k0 = 64 * kb, n0 = 32 * nb;
    const int col = permuted ? orig_col(n0 + (lane & 31)) : n0 + (lane & 31);
#pragma unroll 8
    for (int i = 0; i < 32; ++i) { const int kk = 2 * i + (lane >> 5); scr[kk * 33 + (lane & 31)] = W[(size_t)(k0 + kk) * ldw + col]; }
    asm volatile("s_waitcnt lgkmcnt(0)" ::: "memory");
    const int c = lane & 7;
#pragma unroll
    for (int j = 0; j < 4; ++j) { const int n = (lane >> 3) + 8 * j; const LAS float* s = scr + (8 * c) * 33 + n;
        v4u o; o.x = pk2(s[0 * 33], s[1 * 33]); o.y = pk2(s[2 * 33], s[3 * 33]); o.z = pk2(s[4 * 33], s[5 * 33]); o.w = pk2(s[6 * 33], s[7 * 33]);
        *(v4u*)(WT + (size_t)(n0 + n) * K + k0 + 8 * c) = o; }
    asm volatile("s_waitcnt lgkmcnt(0)" ::: "memory");
}
__device__ const float ROPE_INVF[32] = {
    1.000000000e+00f, 7.498942018e-01f, 5.623413324e-01f, 4.216965139e-01f, 3.162277639e-01f, 2.371373773e-01f, 1.778279394e-01f, 1.333521456e-01f,
    1.000000015e-01f, 7.498942316e-02f, 5.623413250e-02f, 4.216964915e-02f, 3.162277490e-02f, 2.371373773e-02f, 1.778279431e-02f, 1.333521400e-02f,
    9.999999776e-03f, 7.498942316e-03f, 5.623413250e-03f, 4.216964822e-03f, 3.162277630e-03f, 2.371373819e-03f, 1.778279431e-03f, 1.333521446e-03f,
    1.000000047e-03f, 7.498941850e-04f, 5.623413017e-04f, 4.216965172e-04f, 3.162277571e-04f, 2.371373703e-04f, 1.778279402e-04f, 1.333521504e-04f };
__device__ __forceinline__ void sincos_acc(float ang, float& c, float& s) {
    const double x = (double)ang; const double kq = __builtin_rint(x * 0.63661977236758134308);
    double r = __builtin_fma(-kq, 1.57079632679489655800, x); r = __builtin_fma(-kq, 6.12323399573676603587e-17, r);
    const double r2 = r * r;
    double sp = -1.0 / 1307674368000.0; sp = sp * r2 + 1.0 / 6227020800.0; sp = sp * r2 - 1.0 / 39916800.0; sp = sp * r2 + 1.0 / 362880.0; sp = sp * r2 - 1.0 / 5040.0; sp = sp * r2 + 1.0 / 120.0; sp = sp * r2 - 1.0 / 6.0;
    const double sn = r + r * r2 * sp;
    double cp = 1.0 / 20922789888000.0; cp = cp * r2 - 1.0 / 87178291200.0; cp = cp * r2 + 1.0 / 479001600.0; cp = cp * r2 - 1.0 / 3628800.0; cp = cp * r2 + 1.0 / 40320.0; cp = cp * r2 - 1.0 / 720.0; cp = cp * r2 + 1.0 / 24.0; cp = cp * r2 - 0.5;
    const double cs = 1.0 + r2 * cp;
    const int q = ((int)kq) & 3;
    const double co = (q == 0) ? cs : (q == 1) ? -sn : (q == 2) ? -cs : sn;
    const double so = (q == 0) ? sn : (q == 1) ? cs : (q == 2) ? -sn : -cs;
    c = (float)co; s = (float)so;
}

struct Args { const float* in[11]; float* out; unsigned char* ws; int ph_lo, ph_hi; };

__global__ void __launch_bounds__(NWAVES * 64, 2) hymba_fwd(Args args) {
    extern __shared__ __attribute__((aligned(16))) unsigned char lds_raw[];
    LAS unsigned char* lds = (LAS unsigned char*)lds_raw;
    volatile LAS int* MISC = (volatile LAS int*)(lds + MISC_OFF);
    const int tid = threadIdx.x, lane = tid & 63, wave = __builtin_amdgcn_readfirstlane(tid >> 6);
    const int G = gridDim.x, bx = blockIdx.x;
    unsigned char* ws = args.ws;
    const float* x = args.in[0]; const float* norm_g = args.in[1]; const float* w_in = args.in[2]; const float* b_forget = args.in[3];
    const float* lq1 = args.in[4]; const float* lk1 = args.in[5]; const float* lq2 = args.in[6]; const float* lk2 = args.in[7];
    const float* subln_g = args.in[8]; const float* w_out = args.in[9]; const float* final_g = args.in[10];
    float* out = args.out;
    unsigned* ctl = (unsigned*)(ws + WS_CTL); float* rowss = (float*)(ws + WS_CTL + CTL_ROWSS);
    bf16* Wt_in = (bf16*)(ws + WS_WIN); bf16* Wt_out = (bf16*)(ws + WS_WOUT); float* rope = (float*)(ws + WS_ROPE);
    float* LOGF = (float*)(ws + WS_LOGF); float* GC = (float*)(ws + WS_G);
    bf16* U = (bf16*)(ws + WS_U); bf16* MIXED = (bf16*)(ws + WS_U); bf16* PROJ = (bf16*)(ws + WS_PROJ); float* STASH = (float*)(ws + WS_STASH);
    const int lo = args.ph_lo, hi_ph = args.ph_hi;
#ifndef PH_MASK
#define PH_MASK 31
#endif
#define IN(k) (((PH_MASK >> (k)) & 1) && lo <= (k) && (k) < hi_ph)
#if USE_CG_SYNC
#define GRID_SYNC(k) do { if (IN(k) && IN((k) + 1)) cg::this_grid().sync(); } while (0)
#else
    for (int u_ = tid; u_ < 64; u_ += NWAVES * 64) ((LAS unsigned*)(lds + MISC_OFF))[u_] = 0u;
    __syncthreads();
    XcdBarrier bar = xcd_barrier_post(ctl + CW_BAR, (volatile LAS unsigned*)(lds + MISC_OFF) + 8);
#define GRID_SYNC(k) do { if (IN(k) && IN((k) + 1)) xcd_barrier(bar); } while (0)
#endif

    if (IN(0)) {
        const int gw = bx * NWAVES + wave, NGW = G * NWAVES;
        LAS float* scr = (LAS float*)(lds + wave * 16384);
        constexpr int I_IN = (DM / 64) * (NPROJ / 32), I_OUT = (DM / 64) * (DM / 32);
        for (int it = gw; it < I_IN + I_OUT; it += NGW) {
            if (it < I_IN) transpose_item(w_in, NCOL_IN, DM, Wt_in, scr, it, NPROJ / 32, lane, true);
            else transpose_item(w_out, DM, DM, Wt_out, scr, it - I_IN, DM / 32, lane, false);
        }
        for (int idx = bx * (NWAVES * 64) + tid; idx < SEQ * 32; idx += G * NWAVES * 64) {
            const int pos = idx >> 5, i = idx & 31; const float ang = (float)pos * ROPE_INVF[i]; float c, s; sincos_acc(ang, c, s);
            *(float2*)(rope + (size_t)idx * 2) = make_float2(c, s);
        }
        __syncthreads();
        LAS float* wfz = (LAS float*)lds;
        for (int k = tid; k < DM; k += NWAVES * 64) { const int j = k >> 8, l = (k & 255) >> 2, e = k & 3; const float* src = w_in + (size_t)k * NCOL_IN + 2048;
            const f32x4 a = *(const f32x4*)src, b = *(const f32x4*)(src + 4); LAS f32x4* d = (LAS f32x4*)(wfz + ((j * 4 + e) * 64 + l) * 8); d[0] = a; d[1] = b; }
        __syncthreads();
        f32x4 gv[4];
#pragma unroll
        for (int j = 0; j < 4; ++j) gv[j] = ((const f32x4*)norm_g)[lane + 64 * j];
        const float bz = b_forget[lane & 7];
        for (int m = gw; m < SEQ; m += NGW) {
            const f32x4* xr = (const f32x4*)(x + (size_t)m * DM) + lane;
            f32x4 v[4]; float s2 = 0.f;
#pragma unroll
            for (int j = 0; j < 4; ++j) { v[j] = xr[64 * j]; s2 += (v[j].x * v[j].x + v[j].y * v[j].y) + (v[j].z * v[j].z + v[j].w * v[j].w); }
            const float rstd = 1.0f / sqrtf(wave_sum(s2) * (1.0f / DM) + EPS);
            unsigned long long* o8 = (unsigned long long*)(U + (size_t)m * DM) + lane;
            float za[8];
#pragma unroll
            for (int c = 0; c < 8; ++c) za[c] = 0.f;
#pragma unroll
            for (int j = 0; j < 4; ++j) { v[j] = v[j] * rstd * gv[j];
                o8[64 * j] = (unsigned long long)pk2(v[j].x, v[j].y) | ((unsigned long long)pk2(v[j].z, v[j].w) << 32);
#pragma unroll
                for (int e = 0; e < 4; ++e) { const LAS f32x4* wp = (const LAS f32x4*)(wfz + ((j * 4 + e) * 64 + lane) * 8); const f32x4 wa = wp[0], wb = wp[1]; const float uv = v[j][e];
                    za[0] += uv * wa.x; za[1] += uv * wa.y; za[2] += uv * wa.z; za[3] += uv * wa.w; za[4] += uv * wb.x; za[5] += uv * wb.y; za[6] += uv * wb.z; za[7] += uv * wb.w; } }
#pragma unroll
            for (int c = 0; c < 8; ++c) za[c] = wave_sum(za[c]);
            const int c = lane & 7;
            float z = (c == 0) ? za[0] : (c == 1) ? za[1] : (c == 2) ? za[2] : (c == 3) ? za[3] : (c == 4) ? za[4] : (c == 5) ? za[5] : (c == 6) ? za[6] : za[7];
            z += bz;
            const float ls = (z >= 0.f) ? -log1pf(expf(-z)) : z - log1pf(expf(z));
            if (lane < 8) LOGF[(size_t)c * SEQ + m] = ls * LOG2E;
        }
    }
    GRID_SYNC(0);

    if (IN(1)) {
        if (bx < 8) {
            const float* lf = LOGF + (size_t)bx * SEQ + tid * 32; float* gc = GC + (size_t)bx * SEQ + tid * 32;
            double p[32]; double run = 0.0;
#pragma unroll
            for (int q = 0; q < 8; ++q) { const f32x4 a = ((const f32x4*)lf)[q];
                run += (double)a.x; p[4 * q] = run; run += (double)a.y; p[4 * q + 1] = run; run += (double)a.z; p[4 * q + 2] = run; run += (double)a.w; p[4 * q + 3] = run; }
            double sc = run;
#pragma unroll
            for (int o = 1; o < 64; o <<= 1) { const double n = __shfl_up(sc, o); if (lane >= o) sc += n; }
            LAS double* wt = (LAS double*)lds;
            if (lane == 63) wt[wave] = sc;
            __syncthreads();
            double base = sc - run;
            for (int q = 0; q < wave; ++q) base += wt[q];
#pragma unroll
            for (int q = 0; q < 8; ++q) { f32x4 o; o.x = (float)(base + p[4 * q]); o.y = (float)(base + p[4 * q + 1]); o.z = (float)(base + p[4 * q + 2]); o.w = (float)(base + p[4 * q + 3]); ((f32x4*)gc)[q] = o; }
            __syncthreads();
        }
        pg8::Gemm g{U, Wt_in, SEQ, NPROJ, DM}; pg8::StaticOrder S; S.init(SEQ, NPROJ, G, bx);
        pg8::EpiProj E{PROJ, rope, ctl + CW_KMAX};
        pg8::gemm_phase<pg8::EpiProj, pg8::StaticOrder, true, true>(lds, g, S, E);
    }
    GRID_SYNC(1);

    if (IN(2)) {
        const float lam = __expf(wave_sum(lq1[lane] * lk1[lane])) - __expf(wave_sum(lq2[lane] * lk2[lane])) + 0.2f;
        for (;;) {
            if (tid == 0) MISC[0] = (int)atomicAdd(ctl + CW_QUEUE, 1u);
            __syncthreads();
            const int idx = MISC[0];
            __syncthreads();
            if (idx >= 1024) break;
            if (idx < 512) att::diff_unit(lds, MISC, PROJ, MIXED, STASH, ctl + CW_TICK, lam, subln_g, idx & 7, 63 - (idx >> 3));
            else att::fox_unit(lds, PROJ, GC, ctl + CW_KMAX, MIXED, (idx - 512) & 7, 63 - ((idx - 512) >> 3));
        }
    }
    GRID_SYNC(2);

    if (IN(3)) {
        pg8::Gemm g{MIXED, Wt_out, SEQ, DM, DM}; pg8::StaticOrder S; S.init(SEQ, DM, G, bx);
        pg8::EpiOut E{x, out, rowss};
        pg8::gemm_phase<pg8::EpiOut, pg8::StaticOrder, false, true>(lds, g, S, E);
    }
    GRID_SYNC(3);

    if (IN(4)) {
        const int gw = bx * NWAVES + wave, NGW = G * NWAVES;
        f32x4 gv[4];
#pragma unroll
        for (int j = 0; j < 4; ++j) gv[j] = ((const f32x4*)final_g)[lane + 64 * j];
        for (int m = gw; m < SEQ; m += NGW) {
            const float rstd = 1.0f / sqrtf(rowss[m] * (1.0f / DM) + EPS);
            f32x4* hr = (f32x4*)(out + (size_t)m * DM) + lane;
#pragma unroll
            for (int j = 0; j < 4; ++j) hr[64 * j] = hr[64 * j] * rstd * gv[j];
        }
    }
#undef IN
#undef GRID_SYNC
}

extern "C" void kernel_launch(void* const* d_in, const int* in_sizes, int n_in, void* d_out, int out_size, void* d_ws, size_t ws_size, hipStream_t stream) {
    static int grid = 0;
    if (grid == 0) {
        if (n_in != 11 || in_sizes[0] != SEQ * DM || out_size != SEQ * DM || ws_size < WS_END) { fprintf(stderr, "kernel_launch: unexpected shapes (n_in %d, ws %zu)\n", n_in, ws_size); grid = -1; return; }
        int dev = 0, cus = 0, per_cu = 0;
        if (hipGetDevice(&dev) != hipSuccess || hipDeviceGetAttribute(&cus, hipDeviceAttributeMultiprocessorCount, dev) != hipSuccess) { grid = -1; return; }
        if (hipFuncSetAttribute((const void*)hymba_fwd, hipFuncAttributeMaxDynamicSharedMemorySize, LDS_BYTES) != hipSuccess) { fprintf(stderr, "kernel_launch: hipFuncSetAttribute failed\n"); grid = -1; return; }
        if (hipOccupancyMaxActiveBlocksPerMultiprocessor(&per_cu, (const void*)hymba_fwd, NWAVES * 64, LDS_BYTES) != hipSuccess || per_cu < 1) { fprintf(stderr, "kernel_launch: occupancy query says %d\n", per_cu); per_cu = 1; }
        (void)hipGetLastError();
        grid = cus;
    }
    if (grid < 0) return;
    (void)hipMemsetAsync((char*)d_ws + WS_CTL, 0, CTL_ZERO_BYTES, stream);
    Args a{};
    for (int i = 0; i < 11; ++i) a.in[i] = (const float*)d_in[i];
    a.out = (float*)d_out; a.ws = (unsigned char*)d_ws;
#if MK_N_LAUNCHES == 1
    a.ph_lo = 0; a.ph_hi = 5;
    void* kargs[] = {&a};
#if USE_CG_SYNC
    hipError_t e = hipLaunchCooperativeKernel((const void*)hymba_fwd, dim3(grid), dim3(NWAVES * 64), kargs, LDS_BYTES, stream);
    if (e != hipSuccess) fprintf(stderr, "kernel_launch: cooperative launch failed: %s (grid %d)\n", hipGetErrorString(e), grid);
#else
    (void)kargs; hipLaunchKernelGGL(hymba_fwd, dim3(grid), dim3(NWAVES * 64), LDS_BYTES, stream, a);
#endif
#else
    for (int ph = 0; ph < 5; ++ph) { a.ph_lo = ph; a.ph_hi = ph + 1; hipLaunchKernelGGL(hymba_fwd, dim3(grid), dim3(NWAVES * 64), LDS_BYTES, stream, a); }
#endif
}
```

```cpp
#include <hip/hip_runtime.h>
#include <hip/hip_cooperative_groups.h>
#include <cstdio>
#include <cstdint>
namespace cg = cooperative_groups;
#ifndef PROBE
#define PROBE 0
#endif
#ifndef MK_N_LAUNCHES
#define MK_N_LAUNCHES 1
#endif
constexpr int SEQ = 16384, DM = 1024, NCOL_IN = 4104, NPROJ = 4096;
constexpr float LOG2E = 1.4426950408889634f;
constexpr float C2F = 0.125f * 1.4426950408889634f;
constexpr float EPS = 1e-6f;
namespace pg8 {
#define PG8_LAS __attribute__((address_space(3)))
typedef unsigned short bf16_t;
typedef short bf16x8 __attribute__((ext_vector_type(8)));
typedef float f32x4 __attribute__((ext_vector_type(4)));
typedef unsigned u32x4 __attribute__((ext_vector_type(4)));
constexpr int BM = 256, BK = 64, HALF = 128, HTB = HALF * BK * 2  , STAGE_BYTES = 8 * HTB, NXCD = 8, WGM = 8;

__host__ __device__ __forceinline__ int lds_byte(int r, int c) { const int st = (r >> 4) * 2 + (c >> 5), rr = r & 15, cc = c & 31, ob = rr * 64 + cc * 2; return st * 1024 + (ob ^ (((ob >> 9) & 1) << 5)); }
__host__ __device__ __forceinline__ void stage_rc(int b, int& R, int& C) { const int st = b / 1024, sb = b % 1024, swz = sb ^ (((sb >> 9) & 1) << 5); R = (st >> 1) * 16 + swz / 64; C = (st & 1) * 32 + (swz % 64) / 2; }
__host__ __device__ __forceinline__ int perm32(int rho) { const int n = rho >> 4, i = rho & 15; return 8 * (i >> 2) + 4 * n + (i & 3); }

struct Unit { int pm, pn; };
struct Gemm { const bf16_t* A; const bf16_t* Bt; int M, N, K; };

struct StaticOrder {
    int nM, nN, nwg, G, c;
    __host__ __device__ void init(int M, int N, int G_, int c_) { nM = M / BM; nN = N / BM; nwg = nM * nN; G = G_; c = c_; }
    __host__ __device__ bool next(int i, Unit& u) const {
        const long L = (long)i * G + c; if (L >= nwg) return false;
        int wgid = (int)L; { const int q = nwg / NXCD, r = nwg % NXCD, xcd = wgid % NXCD, off = wgid / NXCD; wgid = (xcd < r ? xcd * (q + 1) : r * (q + 1) + (xcd - r) * q) + off; }
        const int nig = WGM * nN, gid = wgid / nig, fm = gid * WGM, gsz = (nM - fm) < WGM ? (nM - fm) : WGM;
        u.pm = fm + ((wgid % nig) % gsz); u.pn = (wgid % nig) / gsz; return true;
    }
    __device__ __forceinline__ void a_ready(const Unit&) const {}
    __device__ __forceinline__ void done(const Unit&) const {}
};


typedef float f32x2 __attribute__((ext_vector_type(2)));
typedef __bf16 bf16x2_t __attribute__((ext_vector_type(2)));
__device__ __forceinline__ unsigned cvt_pk_bf16(float lo, float hi) { f32x2 v = {lo, hi}; bf16x2_t b = __builtin_convertvector(v, bf16x2_t); return __builtin_bit_cast(unsigned, b); }
__device__ __forceinline__ float silu_f(float v) { return v * __builtin_amdgcn_rcpf(1.0f + __builtin_amdgcn_exp2f(-LOG2E * v)); }

struct EpiProj {
    static constexpr bool PERM = true, AFTER_DRAIN = false;
    bf16_t* P; const float* rope; unsigned* kmax;
    template <int MODE  >
    __device__ __forceinline__ void run(const f32x4 (&acc)[2][2][4][2], const Unit& u, int wr, int wc, int fr, int fq) const {
        const int row0 = u.pm * BM + wr * 64 + fr, within = 32 * (wc & 1) + 8 * fq, slot0 = 4 * u.pn + (wc >> 1);
#pragma unroll
        for (int ai = 0; ai < 2; ++ai)
#pragma unroll
            for (int m = 0; m < 4; ++m) {
                const int row = row0 + ai * HALF + m * 16;
                f32x4 c01 = {1.f, 0.f, 1.f, 0.f}, c23 = {1.f, 0.f, 1.f, 0.f};
                if (MODE >= 3) { const f32x4* rp = (const f32x4*)(rope + ((size_t)row * 32 + 16 * (wc & 1) + 4 * fq) * 2); c01 = rp[0]; c23 = rp[1]; }
#pragma unroll
                for (int bj = 0; bj < 2; ++bj) {
                    f32x4 v0 = acc[ai][bj][m][0], v1 = acc[ai][bj][m][1];
                    if (MODE >= 3) {
                        f32x4 r0, r1;
                        r0[0] = v0[0] * c01[0] - v0[1] * c01[1]; r0[1] = v0[1] * c01[0] + v0[0] * c01[1];
                        r0[2] = v0[2] * c01[2] - v0[3] * c01[3]; r0[3] = v0[3] * c01[2] + v0[2] * c01[3];
                        r1[0] = v1[0] * c23[0] - v1[1] * c23[1]; r1[1] = v1[1] * c23[0] + v1[0] * c23[1];
                        r1[2] = v1[2] * c23[2] - v1[3] * c23[3]; r1[3] = v1[3] * c23[2] + v1[2] * c23[3];
                        v0 = r0; v1 = r1;
                    }
                    if (MODE == 1 || MODE == 4) { v0 = v0 * C2F; v1 = v1 * C2F; }
                    if (MODE == 2) { v0[0] = silu_f(v0[0]); v0[1] = silu_f(v0[1]); v0[2] = silu_f(v0[2]); v0[3] = silu_f(v0[3]);
                                     v1[0] = silu_f(v1[0]); v1[1] = silu_f(v1[1]); v1[2] = silu_f(v1[2]); v1[3] = silu_f(v1[3]); }
                    u32x4 w; w.x = cvt_pk_bf16(v0[0], v0[1]); w.y = cvt_pk_bf16(v0[2], v0[3]); w.z = cvt_pk_bf16(v1[0], v1[1]); w.w = cvt_pk_bf16(v1[2], v1[3]);
                    *(u32x4*)(P + ((size_t)(slot0 + 2 * bj) * SEQ + row) * 64 + within) = w;
                }
            }
    }
    __device__ __forceinline__ void operator()(const f32x4 (&acc)[2][2][4][2], const Unit& u, int wr, int wc, int fr, int fq) const {
        const int g = u.pn >> 1;
        if (g == 0) run<1>(acc, u, wr, wc, fr, fq);
        else if (g == 3 || g == 7) run<2>(acc, u, wr, wc, fr, fq);
        else if (g == 4) run<4>(acc, u, wr, wc, fr, fq);
        else if (g == 5) run<3>(acc, u, wr, wc, fr, fq);
        else run<0>(acc, u, wr, wc, fr, fq);
        if (g == 1) {
            const int lane = fr + 16 * fq;
#pragma unroll
            for (int bj = 0; bj < 2; ++bj) { float mx = 0.f;
#pragma unroll
                for (int ai = 0; ai < 2; ++ai)
#pragma unroll
                    for (int m = 0; m < 4; ++m) { const f32x4 v0 = acc[ai][bj][m][0], v1 = acc[ai][bj][m][1];
                        float ss = (v0[0] * v0[0] + v0[1] * v0[1]) + (v0[2] * v0[2] + v0[3] * v0[3]) + (v1[0] * v1[0] + v1[1] * v1[1]) + (v1[2] * v1[2] + v1[3] * v1[3]);
                        ss += __shfl_xor(ss, 16); ss += __shfl_xor(ss, 32); mx = __builtin_fmaxf(mx, ss); }
                mx = __builtin_fmaxf(mx, __shfl_xor(mx, 1)); mx = __builtin_fmaxf(mx, __shfl_xor(mx, 2)); mx = __builtin_fmaxf(mx, __shfl_xor(mx, 4)); mx = __builtin_fmaxf(mx, __shfl_xor(mx, 8));
                if (lane == 0) atomicMax(kmax + (((u.pn - 2) * 4 + 2 * bj + (wc >> 1)) * 2 + (wc & 1)), __float_as_uint(mx)); }
        }
    }
};

struct EpiOut {
    static constexpr bool PERM = false, AFTER_DRAIN = false;
    const float* x; float* out; float* rowss;
    __device__ __forceinline__ void operator()(const f32x4 (&acc)[2][2][4][2], const Unit& u, int wr, int wc, int fr, int fq) const {
        const int col0 = u.pn * BM + wc * 32 + 4 * fq;
#pragma unroll
        for (int ai = 0; ai < 2; ++ai)
#pragma unroll
            for (int m = 0; m < 4; ++m) {
                const int row = u.pm * BM + ai * HALF + wr * 64 + m * 16 + fr; const size_t off = (size_t)row * DM + col0; float ss = 0.f;
#pragma unroll
                for (int bj = 0; bj < 2; ++bj)
#pragma unroll
                    for (int n = 0; n < 2; ++n) { const f32x4 xv = *(const f32x4*)(x + off + bj * HALF + n * 16); const f32x4 h = xv + acc[ai][bj][m][n];
                        *(f32x4*)(out + off + bj * HALF + n * 16) = h; ss += (h[0] * h[0] + h[1] * h[1]) + (h[2] * h[2] + h[3] * h[3]); }
                ss += __shfl_xor(ss, 16); ss += __shfl_xor(ss, 32);
                if (fq == 0) unsafeAtomicAdd(rowss + row, ss);
            }
    }
};

template <class Epi, class Sched, bool ALIGN_EPI = false, bool SP2 = false>
__device__ __forceinline__ void gemm_phase(PG8_LAS unsigned char* lds, const Gemm g, const Sched& S, const Epi& E) {
    int tid_ = threadIdx.x; asm volatile("" : "+v"(tid_));
    const int tid = tid_, wid = __builtin_amdgcn_readfirstlane(tid >> 6), lane = tid & 63, wr = wid >> 2, wc = wid & 3, fr = lane & 15, fq = lane >> 4;
    const int K = g.K, nt = K / BK;
    unsigned voffA[2], voffB[2];
#pragma unroll
    for (int i = 0; i < 2; ++i) { int R, C; stage_rc(tid * 16 + i * 8192, R, C); const int Rb = Epi::PERM ? ((R & ~31) + perm32(R & 31)) : R;
        voffA[i] = (unsigned)(R * K + C) * 2u; voffB[i] = (unsigned)(Rb * K + C) * 2u; }
    const size_t kstep = (size_t)(BK * 2);
    const size_t hstep = (size_t)HALF * K * 2;
    const size_t tstep = 2 * hstep;
    const unsigned ldsw = (unsigned)wid * 1024u;
    const int aoff = lds_byte(wr * 64 + fr, fq * 8), boff = lds_byte(wc * 32 + fr, fq * 8);
#define PG8_SA(b, h) (((b) * 2 + (h)) * HTB)
#define PG8_SB(b, h) ((4 + (b) * 2 + (h)) * HTB)
#define PG8_STAGE(bufoff, gbase, voff) do { _Pragma("unroll") for (int _i = 0; _i < 2; ++_i) \
        __builtin_amdgcn_global_load_lds((const unsigned*)((const char*)(gbase) + (voff)[_i]), (PG8_LAS unsigned*)(lds + (bufoff) + ldsw + _i * 8192), 16, 0, 0); } while (0)
#define PG8_LDA(dst, b, h) do { _Pragma("unroll") for (int m = 0; m < 4; ++m) _Pragma("unroll") for (int k = 0; k < 2; ++k) dst[m][k] = *(const PG8_LAS bf16x8*)(lds + PG8_SA(b, h) + aoff + m * 2048 + k * 1024); } while (0)
#define PG8_LDB(dst, b, h) do { _Pragma("unroll") for (int n = 0; n < 2; ++n) _Pragma("unroll") for (int k = 0; k < 2; ++k) dst[n][k] = *(const PG8_LAS bf16x8*)(lds + PG8_SB(b, h) + boff + n * 2048 + k * 1024); } while (0)
#define PG8_MMA(ai, bj, At, Bt) do { __builtin_amdgcn_s_setprio(1); _Pragma("unroll") for (int m = 0; m < 4; ++m) _Pragma("unroll") for (int n = 0; n < 2; ++n) _Pragma("unroll") for (int k = 0; k < 2; ++k) \
        acc[ai][bj][m][n] = __builtin_amdgcn_mfma_f32_16x16x32_bf16(Bt[n][k], At[m][k], acc[ai][bj][m][n], 0, 0, 0); __builtin_amdgcn_s_setprio(0); } while (0)
#define PG8_WAIT_V(n) asm volatile("s_waitcnt vmcnt(" #n ")" ::: "memory")
#define PG8_WAIT_L(n) asm volatile("s_waitcnt lgkmcnt(" #n ")" ::: "memory")
#define PG8_BAR __builtin_amdgcn_s_barrier()
#define PG8_SCHED __builtin_amdgcn_sched_barrier(0)
    Unit cur, nxt; int ui = 0;
    if (!S.next(0, cur)) return;
    f32x4 acc[2][2][4][2];
#pragma unroll
    for (int a = 0; a < 2; ++a)
#pragma unroll
        for (int b = 0; b < 2; ++b)
#pragma unroll
            for (int m = 0; m < 4; ++m)
#pragma unroll
                for (int n = 0; n < 2; ++n) acc[a][b][m][n] = (f32x4){0.f, 0.f, 0.f, 0.f};
    bf16x8 At[4][2], B0[2][2], B1[2][2];
    const char* cA = (const char*)g.A + (size_t)cur.pm * tstep; const char* cB = (const char*)g.Bt + (size_t)cur.pn * tstep;
    S.a_ready(cur);
    if constexpr (SP2) {
        PG8_STAGE(PG8_SB(0, 0), cB, voffB); PG8_STAGE(PG8_SB(0, 1), cB + hstep, voffB); PG8_STAGE(PG8_SA(0, 0), cA, voffA); PG8_STAGE(PG8_SA(0, 1), cA + hstep, voffA);
        if (wr == 1) PG8_BAR;
        PG8_WAIT_V(2); PG8_BAR;
        PG8_STAGE(PG8_SB(1, 0), cB + kstep, voffB); PG8_STAGE(PG8_SA(1, 0), cA + kstep, voffA); PG8_STAGE(PG8_SB(1, 1), cB + hstep + kstep, voffB);
        PG8_WAIT_V(6); PG8_BAR;
    } else {
        PG8_STAGE(PG8_SB(0, 0), cB, voffB); PG8_STAGE(PG8_SA(0, 0), cA, voffA); PG8_STAGE(PG8_SB(0, 1), cB + hstep, voffB); PG8_STAGE(PG8_SA(0, 1), cA + hstep, voffA);
        if (wr == 1) PG8_BAR;
        PG8_WAIT_V(4); PG8_BAR;
        PG8_STAGE(PG8_SB(1, 0), cB + kstep, voffB); PG8_STAGE(PG8_SA(1, 0), cA + kstep, voffA); PG8_STAGE(PG8_SB(1, 1), cB + hstep + kstep, voffB);
        PG8_WAIT_V(6); PG8_BAR;
    }
    for (;;) {
        const bool has_next = S.next(ui + 1, nxt);
        const char* nA = has_next ? (const char*)g.A + (size_t)nxt.pm * tstep : cA; const char* nB = has_next ? (const char*)g.Bt + (size_t)nxt.pn * tstep : cB;
        for (int t = 0; t < nt; t += 2) {
            const bool last = (t == nt - 2);
            const char* a1 = cA + (size_t)(t + 1) * kstep;
            const char* a2 = last ? nA : cA + (size_t)(t + 2) * kstep; const char* b2 = last ? nB : cB + (size_t)(t + 2) * kstep;
            const char* a3 = a2 + kstep; const char* b3 = b2 + kstep;
            if (last && has_next) S.a_ready(nxt);
            if constexpr (SP2) {
            PG8_LDB(B0, 0, 0); PG8_LDB(B1, 0, 1); PG8_SCHED; PG8_LDA(At, 0, 0); PG8_STAGE(PG8_SA(1, 1), a1 + hstep, voffA);
            PG8_WAIT_V(8); PG8_WAIT_L(0); PG8_BAR; PG8_MMA(0, 0, At, B0); PG8_MMA(0, 1, At, B1); PG8_BAR; PG8_SCHED;
            PG8_LDA(At, 0, 1); PG8_STAGE(PG8_SB(0, 0), b2, voffB); PG8_STAGE(PG8_SB(0, 1), b2 + hstep, voffB); PG8_STAGE(PG8_SA(0, 0), a2, voffA);
            PG8_WAIT_V(8); PG8_WAIT_L(0); PG8_BAR; PG8_MMA(1, 0, At, B0); PG8_MMA(1, 1, At, B1); PG8_BAR; PG8_SCHED;
            PG8_LDB(B0, 1, 0); PG8_LDB(B1, 1, 1); PG8_SCHED; PG8_LDA(At, 1, 0); PG8_STAGE(PG8_SA(0, 1), a2 + hstep, voffA);
            PG8_WAIT_V(8); PG8_WAIT_L(0); PG8_BAR; PG8_MMA(0, 0, At, B0); PG8_MMA(0, 1, At, B1); PG8_BAR; PG8_SCHED;
            PG8_LDA(At, 1, 1); PG8_STAGE(PG8_SB(1, 0), b3, voffB); PG8_STAGE(PG8_SB(1, 1), b3 + hstep, voffB); PG8_STAGE(PG8_SA(1, 0), a3, voffA);
            PG8_WAIT_V(8); PG8_WAIT_L(0); PG8_BAR; PG8_MMA(1, 0, At, B0); PG8_MMA(1, 1, At, B1); PG8_BAR; PG8_SCHED;
            } else {
            PG8_LDB(B0, 0, 0); PG8_SCHED; PG8_LDA(At, 0, 0); PG8_STAGE(PG8_SA(1, 1), a1 + hstep, voffA);
            PG8_WAIT_L(8); PG8_BAR; PG8_WAIT_L(0); PG8_MMA(0, 0, At, B0); PG8_BAR; PG8_SCHED;
            PG8_LDB(B1, 0, 1); PG8_STAGE(PG8_SB(0, 0), b2, voffB);
            PG8_BAR; PG8_WAIT_L(0); PG8_MMA(0, 1, At, B1); PG8_BAR;
            PG8_LDA(At, 0, 1); PG8_STAGE(PG8_SA(0, 0), a2, voffA);
            PG8_BAR; PG8_WAIT_L(0); PG8_MMA(1, 0, At, B0); PG8_BAR; PG8_SCHED;
            PG8_STAGE(PG8_SB(0, 1), b2 + hstep, voffB);
            PG8_WAIT_V(6); PG8_BAR; PG8_MMA(1, 1, At, B1); PG8_BAR;
            PG8_LDB(B0, 1, 0); PG8_SCHED; PG8_LDA(At, 1, 0); PG8_STAGE(PG8_SA(0, 1), a2 + hstep, voffA);
            PG8_WAIT_L(8); PG8_BAR; PG8_WAIT_L(0); PG8_MMA(0, 0, At, B0); PG8_BAR; PG8_SCHED;
            PG8_LDB(B1, 1, 1); PG8_STAGE(PG8_SB(1, 0), b3, voffB);
            PG8_BAR; PG8_WAIT_L(0); PG8_MMA(0, 1, At, B1); PG8_BAR;
            PG8_LDA(At, 1, 1); PG8_STAGE(PG8_SA(1, 0), a3, voffA);
            PG8_BAR; PG8_WAIT_L(0); PG8_MMA(1, 0, At, B0); PG8_BAR; PG8_SCHED;
            PG8_STAGE(PG8_SB(1, 1), b3 + hstep, voffB);
            PG8_WAIT_V(6); PG8_BAR; PG8_MMA(1, 1, At, B1); PG8_BAR;
            }
        }
        if constexpr (ALIGN_EPI) { if (wr == 0) PG8_BAR; }
        if constexpr (!Epi::AFTER_DRAIN) { E(acc, cur, wr, wc, fr, fq); S.done(cur); }
        if (!has_next) break;
#pragma unroll
        for (int a = 0; a < 2; ++a)
#pragma unroll
            for (int b = 0; b < 2; ++b)
#pragma unroll
                for (int m = 0; m < 4; ++m)
#pragma unroll
                    for (int n = 0; n < 2; ++n) acc[a][b][m][n] = (f32x4){0.f, 0.f, 0.f, 0.f};
        cur = nxt; cA = nA; cB = nB; ++ui;
        if constexpr (ALIGN_EPI) { if (wr == 1) PG8_BAR; }
    }
    PG8_WAIT_V(0);
    if constexpr (!ALIGN_EPI) { if (wr == 0) PG8_BAR; }
    PG8_BAR;
    if constexpr (Epi::AFTER_DRAIN) { E.fused(acc, cur, wr, wc, fr, fq, lds, wid, lane); S.done(cur); }
#undef PG8_SA
#undef PG8_SB
#undef PG8_STAGE
#undef PG8_LDA
#undef PG8_LDB
#undef PG8_MMA
#undef PG8_WAIT_V
#undef PG8_WAIT_L
#undef PG8_BAR
#undef PG8_SCHED
}
}

namespace att {
#define LAS __attribute__((address_space(3)))
typedef unsigned short bf16_t;
typedef short bf16x8 __attribute__((ext_vector_type(8)));
typedef short s16x4 __attribute__((ext_vector_type(4)));
typedef short v4i16_t __attribute__((ext_vector_type(4)));
typedef float f32x16 __attribute__((ext_vector_type(16)));
typedef float f32x4 __attribute__((ext_vector_type(4)));
typedef float f32x2 __attribute__((ext_vector_type(2)));
typedef unsigned u32x4 __attribute__((ext_vector_type(4)));
typedef __bf16 bf16x2_t __attribute__((ext_vector_type(2)));
constexpr int KSLOT = 8192, VSLOT = 16384;
constexpr int K_OFF = 0, V_OFF = 3 * KSLOT, G_OFF = 86016, FLAG_OFF = G_OFF + 1024, WSF_OFF = FLAG_OFF + 256, RING_END = WSF_OFF + 8 * 256;
constexpr int OST_OFF = 0, ATT_BYTES = RING_END;
static_assert(OST_OFF + 8 * 8192 <= G_OFF && V_OFF + 3 * VSLOT <= G_OFF, "the output stages and the rings must stay clear of the G ring / flags / wsf words");
constexpr float THR = 8.0f;
__device__ __forceinline__ int crow(int r, int hi) { return (r & 3) + 8 * (r >> 2) + 4 * hi; }
__device__ __forceinline__ unsigned cvtpk(float lo, float hi) { f32x2 v = {lo, hi}; bf16x2_t b = __builtin_convertvector(v, bf16x2_t); return __builtin_bit_cast(unsigned, b); }
__device__ __forceinline__ void glds16(const void* g, unsigned lds_dst) { unsigned keep;
    asm volatile("s_mov_b32 %0, m0\n\ts_mov_b32 m0, %2\n\ts_nop 0\n\tglobal_load_lds_dwordx4 %1, off\n\ts_mov_b32 m0, %0" : "=&s"(keep) : "v"(g), "s"(lds_dst) : "memory"); }
__device__ __forceinline__ void glds16s(const void* sbase, unsigned voff, unsigned lds_dst) { unsigned keep;
    asm volatile("s_mov_b32 %0, m0\n\ts_mov_b32 m0, %3\n\ts_nop 0\n\tglobal_load_lds_dwordx4 %1, %2\n\ts_mov_b32 m0, %0" : "=&s"(keep) : "v"(voff), "s"(sbase), "s"(lds_dst) : "memory"); }
__device__ __forceinline__ void glds4(const void* g, unsigned lds_dst) { unsigned keep;
    asm volatile("s_mov_b32 %0, m0\n\ts_mov_b32 m0, %2\n\ts_nop 0\n\tglobal_load_lds_dword %1, off\n\ts_mov_b32 m0, %0" : "=&s"(keep) : "v"(g), "s"(lds_dst) : "memory"); }
#define ATT_WAIT_BAR0() asm volatile("s_waitcnt vmcnt(0) lgkmcnt(0)\n\ts_barrier" ::: "memory")
#define ATT_MFMA(a, b, c) __builtin_amdgcn_mfma_f32_32x32x16_bf16(a, b, c, 0, 0, 0)
#define ATT_SBAR() __builtin_amdgcn_sched_barrier(0)
__device__ __forceinline__ s16x4 vtr(LAS const unsigned char* p) { return __builtin_bit_cast(s16x4, __builtin_amdgcn_ds_read_tr16_b64_v4i16((LAS v4i16_t*)p)); }
__device__ __forceinline__ float rowmax32(const f32x16& p0, const f32x16& p1) {
    float a = __builtin_fmaxf(p0[0], p1[0]);
#pragma unroll
    for (int r = 1; r < 16; ++r) a = __builtin_fmaxf(__builtin_fmaxf(a, p0[r]), p1[r]);
    auto rr = __builtin_amdgcn_permlane32_swap(__float_as_uint(a), __float_as_uint(a), false, false);
    return __builtin_fmaxf(__uint_as_float(rr[0]), __uint_as_float(rr[1]));
}
__device__ __forceinline__ float halfsum(float v) {
    auto rr = __builtin_amdgcn_permlane32_swap(__float_as_uint(v), __float_as_uint(v), false, false);
    return __uint_as_float(rr[0]) + __uint_as_float(rr[1]);
}

template <int DV, bool FOX>
__device__ __forceinline__ void attn_pass(LAS unsigned char* lds, const bf16_t* __restrict__ Qh, const bf16_t* __restrict__ Kh, const bf16_t* __restrict__ Va, const bf16_t* __restrict__ Vb,
                                          const float* __restrict__ Gh, const unsigned* __restrict__ kmx, int qb, f32x16 (&o)[DV / 32], float& l_out) {
    int tid_ = threadIdx.x; asm volatile("" : "+v"(tid_)); const int tid = tid_, lane = tid & 63, r32 = lane & 31, hi = lane >> 5;
    const int w = __builtin_amdgcn_readfirstlane(tid >> 6);
    const int q0 = qb * 256, NTu = 4 * qb + 4, my_nt = 4 * qb + (w >> 1) + 1;
    const unsigned lds0 = (unsigned)(uintptr_t)lds;
    LAS float* wsf = (LAS float*)(lds + WSF_OFF) + w * 64;
    const bf16_t* ksrc = Kh + (size_t)lane * 64 + w * 8;
    const size_t voff = (size_t)(16 * (w & 3) + (lane >> 2)) * 64 + (w >> 2) * 32 + (lane & 3) * 8;
    const bf16_t* vsrcA = Va + voff; const bf16_t* vsrcB = (DV == 128) ? Vb + voff : Va;
    const unsigned kdst = lds0 + K_OFF + w * 1024, vdstA = lds0 + V_OFF + w * 1024, vdstB = lds0 + V_OFF + (w + 8) * 1024, gdst = lds0 + G_OFF;
#define ATT_TILE(i) (FOX ? NTu - 1 - (i) : (i))
#define ATT_DMA_K(i, sl) do { const int t_ = ATT_TILE(i); glds16(ksrc + (size_t)t_ * 4096, (unsigned)__builtin_amdgcn_readfirstlane(kdst + (sl) * KSLOT)); \
        if (FOX) { if (w == 0) glds4(Gh + (size_t)t_ * 64 + lane, (unsigned)__builtin_amdgcn_readfirstlane(gdst + (sl) * 256)); } } while (0)
#define ATT_DMA_V(i, sl) do { const size_t to_ = (size_t)ATT_TILE(i) * 4096; glds16(vsrcA + to_, (unsigned)__builtin_amdgcn_readfirstlane(vdstA + (sl) * VSLOT)); \
        if (DV == 128) glds16(vsrcB + to_, (unsigned)__builtin_amdgcn_readfirstlane(vdstB + (sl) * VSLOT)); } while (0)
#define ATT_BAR() asm volatile("s_waitcnt lgkmcnt(0)\n\ts_barrier" ::: "memory")
#define ATT_WAITV_BAR(tail) do { if (tail) asm volatile("s_waitcnt vmcnt(0)" ::: "memory"); else if (DV == 128) asm volatile("s_waitcnt vmcnt(3)" ::: "memory"); else asm volatile("s_waitcnt vmcnt(2)" ::: "memory"); ATT_BAR(); } while (0)
    ATT_DMA_K(0, 0); ATT_DMA_V(0, 0); ATT_DMA_K(1, 1); ATT_DMA_V(1, 1);
    bf16x8 qr[4];
    { const bf16_t* Qw = Qh + (size_t)(q0 + 32 * w + r32) * 64 + hi * 8;
#pragma unroll
      for (int d0 = 0; d0 < 4; ++d0) qr[d0] = *(const bf16x8*)(Qw + d0 * 16); }
    const float gq = FOX ? Gh[q0 + 32 * w + r32] : 0.f;
    float bq = 0.f;
    if (FOX) { float n1 = 0.f, n2 = 0.f;
#pragma unroll
        for (int e = 0; e < 8; ++e) { const float a0 = __uint_as_float((unsigned)(unsigned short)qr[0][e] << 16), a1 = __uint_as_float((unsigned)(unsigned short)qr[1][e] << 16),
                                                  a2 = __uint_as_float((unsigned)(unsigned short)qr[2][e] << 16), a3 = __uint_as_float((unsigned)(unsigned short)qr[3][e] << 16);
            n1 += a0 * a0 + a1 * a1; n2 += a2 * a2 + a3 * a3; }
        n1 = halfsum(n1); n2 = halfsum(n2);
        const unsigned k1 = __hip_atomic_load(kmx, __ATOMIC_RELAXED, __HIP_MEMORY_SCOPE_AGENT), k2 = __hip_atomic_load(kmx + 1, __ATOMIC_RELAXED, __HIP_MEMORY_SCOPE_AGENT);
        bq = 1.01f * (sqrtf(n1) * sqrtf(__uint_as_float(k1)) + sqrtf(n2) * sqrtf(__uint_as_float(k2))); }
    float cref = gq;
    f32x16 cinit;
#pragma unroll
    for (int r = 0; r < 16; ++r) cinit[r] = gq;
    float l = 0.f;
#pragma unroll
    for (int d = 0; d < DV / 32; ++d)
#pragma unroll
        for (int r = 0; r < 16; ++r) o[d][r] = 0.f;
    bool first = true;
    asm volatile("" : "+v"(qr[0]), "+v"(qr[1]), "+v"(qr[2]), "+v"(qr[3]));
    asm volatile("s_waitcnt vmcnt(0)" ::: "memory"); ATT_BAR();
    if (w >= 4) ATT_BAR();
    int sl = 0, sl2 = 2;
    for (int i = 0; i < NTu; ++i) {
        const int t = ATT_TILE(i);
        if (FOX && i > 0) {
            const int fs = (sl == 0) ? 2 : sl - 1;
            const u32x4 fa = *(LAS const u32x4*)(lds + FLAG_OFF + fs * 32), fb = *(LAS const u32x4*)(lds + FLAG_OFF + fs * 32 + 16);
            const unsigned all_ = (fa.x & fa.y) & (fa.z & fa.w) & (fb.x & fb.y) & (fb.z & fb.w);
            if (__builtin_amdgcn_readfirstlane(all_) != 0u) break;
        }
        const bool tail = (i + 2 >= NTu);
        const bool act = (t < my_nt);
        if (!tail) ATT_DMA_K(i + 2, sl2);
        unsigned done_w = 0u; bool resc = false; u32x4 pw[4];
        if (act) {
            LAS const unsigned char* kp = lds + K_OFF + sl * KSLOT + hi * 1024 + r32 * 16;
            f32x16 p0, p1; bf16x8 kf[8]; f32x4 ga[4], gb[4];
#pragma unroll
            for (int d0 = 0; d0 < 4; ++d0) { kf[2 * d0] = *(LAS const bf16x8*)(kp + d0 * 2048); kf[2 * d0 + 1] = *(LAS const bf16x8*)(kp + d0 * 2048 + 512); }
            ATT_SBAR();
            asm volatile("" : "+v"(kf[0]), "+v"(kf[1])); p0 = ATT_MFMA(kf[0], qr[0], cinit); p1 = ATT_MFMA(kf[1], qr[0], cinit); ATT_SBAR();
            asm volatile("" : "+v"(kf[2]), "+v"(kf[3])); p0 = ATT_MFMA(kf[2], qr[1], p0); p1 = ATT_MFMA(kf[3], qr[1], p1); ATT_SBAR();
            asm volatile("" : "+v"(kf[4]), "+v"(kf[5])); p0 = ATT_MFMA(kf[4], qr[2], p0); p1 = ATT_MFMA(kf[5], qr[2], p1); ATT_SBAR();
            asm volatile("" : "+v"(kf[6]), "+v"(kf[7])); p0 = ATT_MFMA(kf[6], qr[3], p0); p1 = ATT_MFMA(kf[7], qr[3], p1); ATT_SBAR();
            if (FOX) {
                { LAS const float* gp = (LAS const float*)(lds + G_OFF + sl * 256) + 4 * hi;
#pragma unroll
                  for (int g = 0; g < 4; ++g) { ga[g] = *(LAS const f32x4*)(gp + 8 * g); gb[g] = *(LAS const f32x4*)(gp + 32 + 8 * g); } }
#pragma unroll
                for (int g = 0; g < 4; ++g) {
#pragma unroll
                    for (int e = 0; e < 4; ++e) { p0[4 * g + e] -= ga[g][e]; p1[4 * g + e] -= gb[g][e]; } }
                if (t == my_nt - 1) {
                    const int lim = 32 * (w & 1) + r32;
#pragma unroll
                    for (int r = 0; r < 16; ++r) { const int kk = crow(r, hi); if (kk > lim) p0[r] = -INFINITY; if (kk + 32 > lim) p1[r] = -INFINITY; }
                }
            }
            const float rm = rowmax32(p0, p1);
            if (first || __any(rm > THR)) {
                const float dl = first ? rm : __builtin_fmaxf(rm, 0.f);
                p0 = p0 - dl; p1 = p1 - dl; cinit = cinit - dl; cref -= dl;
                if (!first) { const float f = __builtin_amdgcn_exp2f(-dl); l *= f; if (hi == 0) wsf[r32] = f; resc = true; }
                first = false;
            }
            float sacc = 0.f;
#pragma unroll
            for (int r = 0; r < 16; ++r) { p0[r] = __builtin_amdgcn_exp2f(p0[r]); p1[r] = __builtin_amdgcn_exp2f(p1[r]); sacc += p0[r] + p1[r]; }
            l += sacc;
            if (PROBE & 32) { float dmy = 0.f;
#pragma unroll
                for (int r = 0; r < 16; ++r) { dmy += __builtin_amdgcn_exp2f(p0[r] - 1.0f) + __builtin_amdgcn_exp2f(p1[r] - 2.0f); }
                asm volatile("" :: "v"(dmy)); }
#pragma unroll
            for (int s = 0; s < 2; ++s) {
                pw[s]     = (u32x4){cvtpk(p0[8 * s], p0[8 * s + 1]), cvtpk(p0[8 * s + 2], p0[8 * s + 3]), cvtpk(p0[8 * s + 4], p0[8 * s + 5]), cvtpk(p0[8 * s + 6], p0[8 * s + 7])};
                pw[2 + s] = (u32x4){cvtpk(p1[8 * s], p1[8 * s + 1]), cvtpk(p1[8 * s + 2], p1[8 * s + 3]), cvtpk(p1[8 * s + 4], p1[8 * s + 5]), cvtpk(p1[8 * s + 6], p1[8 * s + 7])};
            }
            if (FOX) {
                const float gt0 = *(LAS const float*)(lds + G_OFF + sl * 256);
                done_w = __all((bq - gt0) + cref + 160.0f < 0.f) ? 1u : 0u;
            }
        }
        if (FOX) { if (lane == 0) *(LAS unsigned*)(lds + FLAG_OFF + sl * 32 + w * 4) = done_w; }
        ATT_WAITV_BAR(tail);
        if (!tail) ATT_DMA_V(i + 2, sl2);
        if (act) {
            if (resc) {
#pragma unroll
                for (int r = 0; r < 16; ++r) { const float fr_ = wsf[crow(r, hi)];
#pragma unroll
                    for (int d = 0; d < DV / 32; ++d) o[d][r] *= fr_; }
            }
            LAS const unsigned char* vp = lds + V_OFF + sl * VSLOT + ((lane >> 4) & 1) * 32 + (lane & 3) * 8 + (4 * hi + ((lane & 15) >> 2)) * 64;
            s16x4 va[8], vb[8];
#define ATT_VRD(dst, d) do { _Pragma("unroll") for (int s_ = 0; s_ < 4; ++s_) { dst[2 * s_] = vtr(vp + (d) * 4096 + s_ * 1024); dst[2 * s_ + 1] = vtr(vp + (d) * 4096 + s_ * 1024 + 512); } } while (0)
#define ATT_PV(src, d) do { _Pragma("unroll") for (int s_ = 0; s_ < 4; ++s_) { const bf16x8 vf_ = (bf16x8){src[2 * s_][0], src[2 * s_][1], src[2 * s_][2], src[2 * s_][3], src[2 * s_ + 1][0], src[2 * s_ + 1][1], src[2 * s_ + 1][2], src[2 * s_ + 1][3]}; \
                o[d] = ATT_MFMA(__builtin_bit_cast(bf16x8, pw[s_]), vf_, o[d]); } } while (0)
#define ATT_VPIN(x) asm volatile("" : "+v"(x[0]), "+v"(x[1]), "+v"(x[2]), "+v"(x[3]), "+v"(x[4]), "+v"(x[5]), "+v"(x[6]), "+v"(x[7]))
            ATT_VRD(va, 0); ATT_VRD(vb, 1); ATT_SBAR();
            ATT_VPIN(va); ATT_PV(va, 0); ATT_SBAR();
            if (PROBE & 16) { const bf16x8 z8 = (bf16x8){0,0,0,0,0,0,0,0};
#pragma unroll
                for (int k_ = 0; k_ < (DV == 128 ? 16 : 8); ++k_) o[k_ & (DV / 32 - 1)] = ATT_MFMA(z8, __builtin_bit_cast(bf16x8, pw[k_ & 3]), o[k_ & (DV / 32 - 1)]); ATT_SBAR(); }
            if (DV == 128) { ATT_VRD(va, 2); ATT_SBAR(); ATT_VPIN(vb); ATT_PV(vb, 1); ATT_SBAR(); ATT_VRD(vb, 3); ATT_SBAR(); ATT_VPIN(va); ATT_PV(va, 2); ATT_SBAR(); ATT_VPIN(vb); ATT_PV(vb, 3); ATT_SBAR(); }
            else { ATT_VPIN(vb); ATT_PV(vb, 1); ATT_SBAR(); }
#undef ATT_VPIN
#undef ATT_VRD
#undef ATT_PV
        }
        ATT_WAITV_BAR(tail);
        sl = (sl == 2) ? 0 : sl + 1; sl2 = (sl2 == 2) ? 0 : sl2 + 1;
    }
    asm volatile("s_waitcnt vmcnt(0)" ::: "memory");
    if (w < 4) ATT_BAR();
    ATT_BAR();
    l_out = halfsum(l);
#undef ATT_TILE
#undef ATT_DMA_K
#undef ATT_DMA_V
#undef ATT_BAR
#undef ATT_WAITV_BAR
}

__device__ __forceinline__ void row_recip(LAS float* wsf, float l, int r32, int hi, float (&rli)[16]) {
    if (hi == 0) wsf[32 + r32] = l;
    __builtin_amdgcn_fence(__ATOMIC_RELEASE, "wavefront");
#pragma unroll
    for (int r = 0; r < 16; ++r) rli[r] = __builtin_amdgcn_rcpf(wsf[32 + crow(r, hi)]);
}
__device__ __forceinline__ void stage_gate_store(LAS float* stg, const f32x16& a0, const f32x16& a1, int lane, int r32, int hi,
                                                 const bf16_t* __restrict__ gate  , bf16_t* __restrict__ outp  ) {
#pragma unroll
    for (int r = 0; r < 16; ++r) { const int orow = crow(r, hi); stg[orow * 64 + r32] = a0[r]; stg[orow * 64 + 32 + r32] = a1[r]; }
    __builtin_amdgcn_fence(__ATOMIC_RELEASE, "wavefront");
#pragma unroll
    for (int i = 0; i < 4; ++i) {
        const int row = i * 8 + (lane >> 3), ch = lane & 7;
        const f32x4 x0 = *(LAS const f32x4*)(stg + row * 64 + ch * 8), x1 = *(LAS const f32x4*)(stg + row * 64 + ch * 8 + 4);
        const u32x4 gv = *(const u32x4*)(gate + (size_t)row * 64 + ch * 8);
        u32x4 ov;
        ov.x = cvtpk(x0[0] * __uint_as_float(gv.x << 16), x0[1] * __uint_as_float(gv.x & 0xffff0000u));
        ov.y = cvtpk(x0[2] * __uint_as_float(gv.y << 16), x0[3] * __uint_as_float(gv.y & 0xffff0000u));
        ov.z = cvtpk(x1[0] * __uint_as_float(gv.z << 16), x1[1] * __uint_as_float(gv.z & 0xffff0000u));
        ov.w = cvtpk(x1[2] * __uint_as_float(gv.w << 16), x1[3] * __uint_as_float(gv.w & 0xffff0000u));
        *(u32x4*)(outp + (size_t)row * DM + ch * 8) = ov;
    }
    __builtin_amdgcn_fence(__ATOMIC_RELEASE, "wavefront");
}

__device__ __forceinline__ const bf16_t* slot_ptr(const bf16_t* P, int s) { return P + (size_t)s * SEQ * 64; }

__device__ __forceinline__ void fox_unit(LAS unsigned char* lds, const bf16_t* P, const float* G, const unsigned* kmax, bf16_t* MIXED, int h, int qb) {
    int tid_ = threadIdx.x; asm volatile("" : "+v"(tid_)); const int tid = tid_, lane = tid & 63, r32 = lane & 31, hi = lane >> 5; const int w = __builtin_amdgcn_readfirstlane(tid >> 6);
    f32x16 o[2]; float l;
    attn_pass<64, true>(lds, slot_ptr(P, h), slot_ptr(P, 8 + h), slot_ptr(P, 16 + h), nullptr, G + (size_t)h * SEQ, kmax + 2 * h, qb, o, l);
    LAS float* wsf = (LAS float*)(lds + WSF_OFF) + w * 64; float rli[16];
    row_recip(wsf, l, r32, hi, rli);
#pragma unroll
    for (int r = 0; r < 16; ++r) { o[0][r] *= rli[r]; o[1][r] *= rli[r]; }
    const int row0 = qb * 256 + 32 * w;
    stage_gate_store((LAS float*)(lds + OST_OFF + w * 8192), o[0], o[1], lane, r32, hi, slot_ptr(P, 24 + h) + (size_t)row0 * 64, MIXED + (size_t)row0 * DM + h * 64);
}

#undef LAS
}

namespace attp {
#define LAS __attribute__((address_space(3)))
using att::bf16_t; using att::bf16x8; using att::s16x4; using att::f32x16; using att::u32x4; using att::crow; using att::cvtpk; using att::glds16; using att::vtr;
constexpr int KSLOT = att::KSLOT, VSLOT = att::VSLOT, WSF_OFF = att::WSF_OFF;
constexpr int K_OFF = 0, V_OFF = 4 * KSLOT;
static_assert(V_OFF + 3 * VSLOT <= att::WSF_OFF, "rings must stay below the per-wave scratch words");
constexpr float THRL = 8.0f;
#define PSBAR() __builtin_amdgcn_sched_barrier(0)
#define PPIN(x) asm volatile("" : "+v"(x))
#define PMFMA(a, b, c) __builtin_amdgcn_mfma_f32_32x32x16_bf16(a, b, c, 0, 0, 0)
#define PWAIT_BAR(N) asm volatile("s_waitcnt vmcnt(" #N ") lgkmcnt(0)\n\ts_barrier" ::: "memory")
#define PMX3(a, b, c) __builtin_fmaxf(__builtin_fmaxf((a), (b)), (c))
typedef LAS const unsigned char* lds_cptr;
__device__ __forceinline__ void kload2(bf16x8* kf, lds_cptr kp, int j) { kf[2 * j] = *(LAS const bf16x8*)(kp + j * 2048); kf[2 * j + 1] = *(LAS const bf16x8*)(kp + j * 2048 + 512); }

__device__ __forceinline__ void diff_pass(LAS unsigned char* lds, const bf16_t* __restrict__ Qh, const bf16_t* __restrict__ Kh, const bf16_t* __restrict__ Va, const bf16_t* __restrict__ Vb,
                                          int qb, f32x16 (&o)[4], float& l_out) {
    int tid_ = threadIdx.x; asm volatile("" : "+v"(tid_)); const int tid = tid_, lane = tid & 63, r32 = lane & 31, hi = lane >> 5; const int wid = __builtin_amdgcn_readfirstlane(tid >> 6);
    const int q0 = qb * 256, NT = 4 * qb + 4;
    const int limw = NT - 4 + (wid >> 1);
    const unsigned lds0 = (unsigned)(uintptr_t)lds;
    LAS float* wsf = (LAS float*)(lds + WSF_OFF) + wid * 64;
    const unsigned kvo = (unsigned)(lane * 128 + wid * 16);
    const unsigned vvo = (unsigned)((16 * (wid & 3) + (lane >> 2)) * 128 + (wid >> 2) * 64 + (lane & 3) * 16);
    const unsigned kdst = lds0 + K_OFF + wid * 1024, vdstA = lds0 + V_OFF + wid * 1024, vdstB = lds0 + V_OFF + (wid + 8) * 1024;
#define DMA_K(t, slotk) att::glds16s((const char*)Kh + (size_t)(t) * 8192, kvo, (unsigned)__builtin_amdgcn_readfirstlane(kdst + (slotk)))
#define DMA_V(t, slotv) do { att::glds16s((const char*)Va + (size_t)(t) * 8192, vvo, (unsigned)__builtin_amdgcn_readfirstlane(vdstA + (slotv))); att::glds16s((const char*)Vb + (size_t)(t) * 8192, vvo, (unsigned)__builtin_amdgcn_readfirstlane(vdstB + (slotv))); } while (0)
    const lds_cptr kp0 = lds + K_OFF + hi * 1024 + r32 * 16;
    const lds_cptr vp0 = lds + V_OFF + ((lane >> 4) & 1) * 32 + (lane & 3) * 8 + (4 * hi + ((lane & 15) >> 2)) * 64;
    DMA_K(0, 0); DMA_V(0, 0); DMA_K(1, KSLOT);
    bf16x8 qr[4];
    { const bf16_t* Qw = Qh + (size_t)(q0 + 32 * wid + r32) * 64 + hi * 8;
#pragma unroll
      for (int d0 = 0; d0 < 4; ++d0) qr[d0] = *(const bf16x8*)(Qw + d0 * 16); }
    float mhat = 0.f, l_reg = 0.f;
#pragma unroll
    for (int d = 0; d < 4; ++d)
#pragma unroll
        for (int r = 0; r < 16; ++r) o[d][r] = 0.f;
    f32x16 negm;
#pragma unroll
    for (int r = 0; r < 16; ++r) negm[r] = 0.f;
    PPIN(negm);
    bool resc = false;
    bf16x8 kw0, kw1, kw2, kw3; s16x4 wl0, wl1, wl2, wl3, wh0, wh1, wh2, wh3; u32x4 pa0, pa1, pa2, pa3, pb0, pb1, pb2, pb3;
    int ks_cur = 0, ks_next = KSLOT, ks_free = 3 * KSLOT, vs_prev = 0, vs_cur = 0, vs_next = VSLOT;
#define ROT() do { ks_free = (ks_free == 3 * KSLOT) ? 0 : ks_free + KSLOT; ks_cur = ks_next; ks_next = (ks_next == 3 * KSLOT) ? 0 : ks_next + KSLOT; vs_prev = vs_cur; vs_cur = vs_next; vs_next = (vs_next == 2 * VSLOT) ? 0 : vs_next + VSLOT; } while (0)
#define KFO(f) (((f) >> 1) * 2048 + ((f) & 1) * 512)
#define KLD(i, f, slot) do { kw##i = *(LAS const bf16x8*)(kp0 + (slot) + KFO(f)); } while (0)
#define KFIRST(slot) do { KLD(0, 0, slot); KLD(1, 1, slot); KLD(2, 2, slot); KLD(3, 3, slot); } while (0)
#define PKW(P, i) cvtpk(P[i], P[i + 1])
    asm volatile("" : "+v"(qr[0]), "+v"(qr[1]), "+v"(qr[2]), "+v"(qr[3]));
    DMA_K(2, 2 * KSLOT);
    PWAIT_BAR(4);
    {
        bf16x8 kf[8]; f32x16 c0, c1;
#pragma unroll
        for (int d0 = 0; d0 < 4; ++d0) kload2(kf, kp0, d0);
        c0 = PMFMA(kf[0], qr[0], negm); c1 = PMFMA(kf[1], qr[0], negm);
#pragma unroll
        for (int d0 = 1; d0 < 4; ++d0) { c0 = PMFMA(kf[2 * d0], qr[d0], c0); c1 = PMFMA(kf[2 * d0 + 1], qr[d0], c1); }
        const float rm = att::rowmax32(c0, c1); mhat = rm; float sacc = 0.f;
#pragma unroll
        for (int r = 0; r < 16; ++r) { c0[r] = __builtin_amdgcn_exp2f(c0[r] - rm); c1[r] = __builtin_amdgcn_exp2f(c1[r] - rm); sacc += c0[r] + c1[r]; negm[r] = -rm; }
        PPIN(negm); l_reg = sacc;
        pa0 = (u32x4){PKW(c0, 0), PKW(c0, 2), PKW(c0, 4), PKW(c0, 6)}; pa1 = (u32x4){PKW(c0, 8), PKW(c0, 10), PKW(c0, 12), PKW(c0, 14)};
        pa2 = (u32x4){PKW(c1, 0), PKW(c1, 2), PKW(c1, 4), PKW(c1, 6)}; pa3 = (u32x4){PKW(c1, 8), PKW(c1, 10), PKW(c1, 12), PKW(c1, 14)};
    }
    PWAIT_BAR(0);
    DMA_K(3, 3 * KSLOT); DMA_V(1, VSLOT); ROT();
    KFIRST(ks_cur);
    PWAIT_BAR(3);
#define PAF(x) __builtin_bit_cast(bf16x8, x)
#define WFR(i) (bf16x8){wl##i[0], wl##i[1], wl##i[2], wl##i[3], wh##i[0], wh##i[1], wh##i[2], wh##i[3]}
#define VOFF(j) (((j) & 3) * 4096 + ((j) >> 2) * 1024)
#define VRDL(i, j) do { wl##i = vtr(vp_ + VOFF(j)); } while (0)
#define VRDH(i, j) do { wh##i = vtr(vp_ + VOFF(j) + 512); } while (0)
#define EX(v) __builtin_amdgcn_exp2f(v)
#define GAPA(MF, R0, R1) do { MF; R0; R1; PSBAR(); } while (0)
#define GAPB(MF, X, i, PWN, k, R0, R1) do { MF; X[i] = EX(X[i]); X[i + 1] = EX(X[i + 1]); sacc += X[i]; sacc += X[i + 1]; PWN[k] = cvtpk(X[i], X[i + 1]); PPIN(sacc); PPIN(PWN); R0; R1; PSBAR(); } while (0)
#define KR1(G, i) do { if (G) { KLD(i, i, ks_next); } } while (0)
#define NOP_ do { } while (0)
#define STEP(PC0, PC1, PC2, PC3, PN0, PN1, PN2, PN3, t, MASK, GK, GV, GL) do { PSBAR(); \
    const lds_cptr vp_ = vp0 + vs_prev; f32x16 C0, C1; \
    GAPA(C0 = PMFMA(kw0, qr[0], negm), KLD(0, 4, ks_cur), VRDL(0, 0)); \
    GAPA(C1 = PMFMA(kw1, qr[0], negm), KLD(1, 5, ks_cur), VRDH(0, 0)); \
    GAPA(C0 = PMFMA(kw2, qr[1], C0),   KLD(2, 6, ks_cur), VRDL(1, 1)); \
    GAPA(C1 = PMFMA(kw3, qr[1], C1),   KLD(3, 7, ks_cur), VRDH(1, 1)); \
    GAPA(C0 = PMFMA(kw0, qr[2], C0),   VRDL(2, 2), NOP_); \
    GAPA(C1 = PMFMA(kw1, qr[2], C1),   VRDH(2, 2), NOP_); \
    GAPA(C0 = PMFMA(kw2, qr[3], C0),   VRDL(3, 3), NOP_); \
    GAPA(C1 = PMFMA(kw3, qr[3], C1),   VRDH(3, 3), NOP_); \
    if (GK) { DMA_K((t) + 3, ks_free); } if (GV) { DMA_V((t) + 1, vs_next); } \
    if (MASK) { if ((t) > limw) { _Pragma("unroll") for (int r = 0; r < 16; ++r) { C0[r] = -INFINITY; C1[r] = -INFINITY; } } } \
    { float a = PMX3(C0[0], C0[1], C1[0]), b = PMX3(C0[2], C0[3], C1[1]); a = PMX3(a, C1[2], C1[3]); \
      _Pragma("unroll") for (int r = 4; r < 16; r += 4) { a = PMX3(a, C0[r], C0[r + 1]); b = PMX3(b, C0[r + 2], C0[r + 3]); a = PMX3(a, C1[r], C1[r + 1]); b = PMX3(b, C1[r + 2], C1[r + 3]); } \
      float rm = __builtin_fmaxf(a, b); { auto rr = __builtin_amdgcn_permlane32_swap(__float_as_uint(rm), __float_as_uint(rm), false, false); rm = __builtin_fmaxf(__uint_as_float(rr[0]), __uint_as_float(rr[1])); } \
      resc = false; \
      if (__builtin_expect(__any(rm > THRL), 0)) { const float dl = __builtin_fmaxf(rm, 0.f); mhat += dl; \
        _Pragma("unroll") for (int r = 0; r < 16; ++r) { C0[r] -= dl; C1[r] -= dl; } \
        _Pragma("unroll") for (int r = 0; r < 16; ++r) negm[r] = -mhat; PPIN(negm); \
        const float f = __builtin_amdgcn_exp2f(-dl); l_reg *= f; if (hi == 0) wsf[r32] = f; resc = true; } } \
    float sacc = 0.f; PSBAR(); \
    GAPB(o[0] = PMFMA(PAF(PC0), WFR(0), o[0]), C0, 0,  PN0, 0, VRDL(0, 4),  VRDH(0, 4)); \
    GAPB(o[1] = PMFMA(PAF(PC0), WFR(1), o[1]), C0, 2,  PN0, 1, VRDL(1, 5),  VRDH(1, 5)); \
    GAPB(o[2] = PMFMA(PAF(PC0), WFR(2), o[2]), C0, 4,  PN0, 2, VRDL(2, 6),  VRDH(2, 6)); \
    GAPB(o[3] = PMFMA(PAF(PC0), WFR(3), o[3]), C0, 6,  PN0, 3, VRDL(3, 7),  VRDH(3, 7)); \
    GAPB(o[0] = PMFMA(PAF(PC1), WFR(0), o[0]), C0, 8,  PN1, 0, VRDL(0, 8),  VRDH(0, 8)); \
    GAPB(o[1] = PMFMA(PAF(PC1), WFR(1), o[1]), C0, 10, PN1, 1, VRDL(1, 9),  VRDH(1, 9)); \
    GAPB(o[2] = PMFMA(PAF(PC1), WFR(2), o[2]), C0, 12, PN1, 2, VRDL(2, 10), VRDH(2, 10)); \
    GAPB(o[3] = PMFMA(PAF(PC1), WFR(3), o[3]), C0, 14, PN1, 3, VRDL(3, 11), VRDH(3, 11)); \
    GAPB(o[0] = PMFMA(PAF(PC2), WFR(0), o[0]), C1, 0,  PN2, 0, VRDL(0, 12), VRDH(0, 12)); \
    GAPB(o[1] = PMFMA(PAF(PC2), WFR(1), o[1]), C1, 2,  PN2, 1, VRDL(1, 13), VRDH(1, 13)); \
    GAPB(o[2] = PMFMA(PAF(PC2), WFR(2), o[2]), C1, 4,  PN2, 2, VRDL(2, 14), VRDH(2, 14)); \
    GAPB(o[3] = PMFMA(PAF(PC2), WFR(3), o[3]), C1, 6,  PN2, 3, VRDL(3, 15), VRDH(3, 15)); \
    GAPB(o[0] = PMFMA(PAF(PC3), WFR(0), o[0]), C1, 8,  PN3, 0, KR1(GL, 0), NOP_); \
    GAPB(o[1] = PMFMA(PAF(PC3), WFR(1), o[1]), C1, 10, PN3, 1, KR1(GL, 1), NOP_); \
    GAPB(o[2] = PMFMA(PAF(PC3), WFR(2), o[2]), C1, 12, PN3, 2, KR1(GL, 2), NOP_); \
    GAPB(o[3] = PMFMA(PAF(PC3), WFR(3), o[3]), C1, 14, PN3, 3, KR1(GL, 3), NOP_); \
    l_reg += sacc; \
    } while (0)
#define STEP_ODD(t, MASK, GK, GV, GL)  STEP(pa0, pa1, pa2, pa3, pb0, pb1, pb2, pb3, t, MASK, GK, GV, GL)
#define STEP_EVEN(t, MASK, GK, GV, GL) STEP(pb0, pb1, pb2, pb3, pa0, pa1, pa2, pa3, t, MASK, GK, GV, GL)
#define RESC() do { if (resc) { _Pragma("unroll") for (int r = 0; r < 16; ++r) { const float f_ = wsf[crow(r, hi)]; o[0][r] *= f_; o[1][r] *= f_; o[2][r] *= f_; o[3][r] *= f_; } } } while (0)
    int t = 1;
    for (; t + 5 < NT; t += 2) {
        STEP_ODD(t, false, true, true, true);      PWAIT_BAR(3); RESC(); ROT();
        STEP_EVEN(t + 1, false, true, true, true); PWAIT_BAR(3); RESC(); ROT();
    }
#define ENDW(tt) do { if ((tt) + 3 < NT) { PWAIT_BAR(3); } else if ((tt) + 2 < NT) { PWAIT_BAR(2); } else { PWAIT_BAR(0); } } while (0)
    for (; t + 1 < NT; t += 2) {
        STEP_ODD(t, true, (t + 3 < NT), (t + 1 < NT), (t + 1 < NT));          ENDW(t);     RESC(); ROT();
        STEP_EVEN(t + 1, true, (t + 4 < NT), (t + 2 < NT), (t + 2 < NT));     ENDW(t + 1); RESC(); ROT();
    }
    STEP_ODD(NT - 1, true, false, false, false); RESC();
    { const lds_cptr vp_ = vp0 + vs_cur;
#pragma unroll
      for (int d = 0; d < 4; ++d) {
          s16x4 lo[4], hh[4];
#pragma unroll
          for (int s = 0; s < 4; ++s) { lo[s] = vtr(vp_ + d * 4096 + s * 1024); hh[s] = vtr(vp_ + d * 4096 + s * 1024 + 512); }
#define DPK(k) (bf16x8){lo[k][0], lo[k][1], lo[k][2], lo[k][3], hh[k][0], hh[k][1], hh[k][2], hh[k][3]}
          o[d] = PMFMA(PAF(pb0), DPK(0), o[d]); o[d] = PMFMA(PAF(pb1), DPK(1), o[d]); o[d] = PMFMA(PAF(pb2), DPK(2), o[d]); o[d] = PMFMA(PAF(pb3), DPK(3), o[d]);
#undef DPK
      } }
    asm volatile("s_waitcnt vmcnt(0) lgkmcnt(0)\n\ts_barrier" ::: "memory");
    l_out = att::halfsum(l_reg);
#undef DMA_K
#undef DMA_V
#undef ROT
#undef PKW
#undef PAF
#undef WFR
#undef VOFF
#undef VRDL
#undef VRDH
#undef EX
#undef GAPA
#undef GAPB
#undef KR1
#undef KFO
#undef KLD
#undef KFIRST
#undef NOP_
#undef STEP
#undef STEP_ODD
#undef STEP_EVEN
#undef RESC
#undef ENDW
}
#undef LAS
}
namespace att {
#define LAS __attribute__((address_space(3)))
constexpr size_t OBUF_MAP_FLOATS = (size_t)4 * 64 * 8 * 64 * 64;
__device__ __forceinline__ void diff_unit(LAS unsigned char* lds, volatile LAS int* misc, const bf16_t* P, bf16_t* MIXED, float* obuf, unsigned* tick, float lam, const float* __restrict__ subln_g, int mp, int qb) {
    int tid_ = threadIdx.x; asm volatile("" : "+v"(tid_)); const int tid = tid_, lane = tid & 63, r32 = lane & 31, hi = lane >> 5; const int w = __builtin_amdgcn_readfirstlane(tid >> 6);
    const int hd = mp >> 1, m = mp & 1;
    LAS float* wsf = (LAS float*)(lds + WSF_OFF) + w * 64; float rli[16];
    f32x16 o[4]; float l;
    attp::diff_pass(lds, slot_ptr(P, 32 + mp), slot_ptr(P, 40 + mp), slot_ptr(P, 48 + 2 * hd), slot_ptr(P, 49 + 2 * hd), qb, o, l);
    row_recip(wsf, l, r32, hi, rli);
    const size_t rec = (((size_t)(hd * 64 + qb) * 8 + w) * 64 + lane) * 64;
    f32x4* mine = (f32x4*)(obuf + (size_t)m * OBUF_MAP_FLOATS + rec);
    const f32x4* other = (const f32x4*)(obuf + (size_t)(m ^ 1) * OBUF_MAP_FLOATS + rec);
#pragma unroll
    for (int d = 0; d < 4; ++d)
#pragma unroll
        for (int r = 0; r < 16; ++r) o[d][r] *= rli[r];
#pragma unroll
    for (int d = 0; d < 4; ++d)
#pragma unroll
        for (int r4 = 0; r4 < 4; ++r4) mine[d * 4 + r4] = (f32x4){o[d][4 * r4], o[d][4 * r4 + 1], o[d][4 * r4 + 2], o[d][4 * r4 + 3]};
    asm volatile("s_waitcnt vmcnt(0)" ::: "memory");
    __syncthreads();
    if (tid == 0) { __builtin_amdgcn_fence(__ATOMIC_RELEASE, "agent"); asm volatile("s_waitcnt vmcnt(0)" ::: "memory");
                    misc[1] = (int)__hip_atomic_fetch_add(tick + hd * 64 + qb, 1u, __ATOMIC_RELAXED, __HIP_MEMORY_SCOPE_AGENT); }
    __syncthreads();
    if ((misc[1] & 1) == 0) return;
    if (tid == 0) { __builtin_amdgcn_fence(__ATOMIC_ACQUIRE, "agent"); asm volatile("s_waitcnt vmcnt(0)" ::: "memory"); }
    __syncthreads();
    const float ca = (m == 0) ? 1.0f : -lam, cb = (m == 0) ? -lam : 1.0f;
    float ss[16];
#pragma unroll
    for (int r = 0; r < 16; ++r) ss[r] = 0.f;
#pragma unroll
    for (int d = 0; d < 4; ++d) {
#pragma unroll
        for (int r4 = 0; r4 < 4; ++r4) { const f32x4 sv = other[d * 4 + r4];
#pragma unroll
            for (int e = 0; e < 4; ++e) { const int r = 4 * r4 + e; const float v = ca * o[d][r] + cb * sv[e]; o[d][r] = v; ss[r] += v * v; } }
        asm volatile("" ::: "memory");
    }
#pragma unroll
    for (int r = 0; r < 16; ++r) { float s_ = ss[r]; s_ += __shfl_xor(s_, 1); s_ += __shfl_xor(s_, 2); s_ += __shfl_xor(s_, 4); s_ += __shfl_xor(s_, 8); s_ += __shfl_xor(s_, 16);
        ss[r] = __builtin_amdgcn_rsqf(s_ * (1.0f / 128.0f) + EPS) * 0.8f; }
#pragma unroll
    for (int d = 0; d < 4; ++d) { const float gs = subln_g[32 * d + r32];
#pragma unroll
        for (int r = 0; r < 16; ++r) o[d][r] *= ss[r] * gs; }
    const int row0 = qb * 256 + 32 * w;
    LAS float* stg = (LAS float*)(lds + OST_OFF + w * 8192);
    stage_gate_store(stg, o[0], o[1], lane, r32, hi, slot_ptr(P, 56 + 2 * hd) + (size_t)row0 * 64, MIXED + (size_t)row0 * DM + 512 + hd * 128);
    stage_gate_store(stg, o[2], o[3], lane, r32, hi, slot_ptr(P, 57 + 2 * hd) + (size_t)row0 * 64, MIXED + (size_t)row0 * DM + 512 + hd * 128 + 64);
}
#undef LAS
}
#define LAS __attribute__((address_space(3)))
#define XB_TMO      128
#define XB_XCNT(j)  (256  + 64 * (j))
#define XB_XSUB(j)  (1280 + 64 * (j))
#define XB_XGEN(j)  (2304 + 64 * (j))
#define XB_TOP      3328
#define XB_TOPGEN   3392
#define XCD_BAR_WORDS 3456
#define XB_SPIN_CAP (1u << 18)

__device__ __forceinline__ unsigned xb_ld(unsigned* p)              { return __hip_atomic_load(p, __ATOMIC_RELAXED, __HIP_MEMORY_SCOPE_AGENT); }
__device__ __forceinline__ unsigned xb_add(unsigned* p, unsigned v) { return __hip_atomic_fetch_add(p, v, __ATOMIC_RELAXED, __HIP_MEMORY_SCOPE_AGENT); }
__device__ __forceinline__ unsigned xb_xcc_id() { return (unsigned)__builtin_amdgcn_s_getreg((3 << 11) | 20) & 0xFu; }
#define XB_SPIN(cond, bar) do { unsigned _sp = 0; while (cond) { __builtin_amdgcn_s_sleep(1); \
    if ((++_sp & 255u) == 0u) { if (xb_ld(&(bar)[XB_TMO])) break; if (_sp > XB_SPIN_CAP) { atomicAdd(&(bar)[XB_TMO], 1u); break; } } } } while (0)

struct XcdBarrier {
    unsigned* bar; unsigned x;
    volatile LAS unsigned* st;
};

__device__ __forceinline__ XcdBarrier xcd_barrier_post(unsigned* bar, volatile LAS unsigned* st) {
    XcdBarrier b; b.bar = bar; b.x = xb_xcc_id(); b.st = st;
    if (threadIdx.x == 0) (void)xb_add(&bar[XB_XCNT(b.x)], 1u);
    return b;
}
__device__ __forceinline__ void xcd_barrier_complete(unsigned* bar, unsigned x, unsigned& nloc, unsigned& nx) {
    const unsigned G = gridDim.x * gridDim.y * gridDim.z;
    unsigned sum, cnt, mine, sp = 0u;
    for (;;) {
        sum = 0u; cnt = 0u; mine = 0u;
#pragma unroll
        for (unsigned j = 0; j < 16; ++j) { const unsigned c = xb_ld(&bar[XB_XCNT(j)]); sum += c; cnt += (c > 0u) ? 1u : 0u; mine = (j == x) ? c : mine; }
        if (sum == G) break;
        __builtin_amdgcn_s_sleep(1);
        if ((++sp & 255u) == 0u) { if (xb_ld(&bar[XB_TMO])) break; if (sp > XB_SPIN_CAP) { atomicAdd(&bar[XB_TMO], 1u); break; } }
    }
    nloc = mine > 0u ? mine : 1u; nx = cnt > 0u ? cnt : 1u;
}

__device__ __forceinline__ void xcd_barrier(const XcdBarrier& b) {
    asm volatile("s_waitcnt vmcnt(0)" ::: "memory");
    __syncthreads();
    if (threadIdx.x == 0) {
        unsigned* bar = b.bar;
        __builtin_amdgcn_s_waitcnt(0);
        unsigned nloc = b.st[0], nx = b.st[1];
        if (nloc == 0u) { xcd_barrier_complete(bar, b.x, nloc, nx); b.st[0] = nloc; b.st[1] = nx; }
        const unsigned old = xb_add(&bar[XB_XSUB(b.x)], 1u);
        const unsigned gen = old / nloc;
        if (old + 1u == (gen + 1u) * nloc) {
            __builtin_amdgcn_fence(__ATOMIC_RELEASE, "agent");
            asm volatile("s_waitcnt vmcnt(0)" ::: "memory");
            const unsigned og = xb_add(&bar[XB_TOP], 1u);
            const unsigned tg = og / nx;
            if (og + 1u == (tg + 1u) * nx) xb_add(&bar[XB_TOPGEN], 1u);
            else XB_SPIN(xb_ld(&bar[XB_TOPGEN]) == tg, bar);
            __builtin_amdgcn_fence(__ATOMIC_ACQUIRE, "agent");
            xb_add(&bar[XB_XGEN(b.x)], 1u);
            asm volatile("s_waitcnt vmcnt(0)" ::: "memory");
        } else {
            XB_SPIN(xb_ld(&bar[XB_XGEN(b.x)]) == gen, bar);
            __builtin_amdgcn_fence(__ATOMIC_ACQUIRE, "agent");
            asm volatile("s_waitcnt vmcnt(0)" ::: "memory");
        }
    }
    __syncthreads();
}
#undef LAS

#define LAS __attribute__((address_space(3)))
typedef unsigned short bf16;
typedef float f32x4 __attribute__((ext_vector_type(4)));
typedef unsigned v4u __attribute__((ext_vector_type(4)));
constexpr int NWAVES = 8;
constexpr size_t MiB = 1u << 20;
constexpr size_t WS_CTL = 0, CTL_ZERO_BYTES = 1 * MiB;
constexpr size_t WS_WIN = 1 * MiB;
constexpr size_t WS_WOUT = 9 * MiB;
constexpr size_t WS_ROPE = 11 * MiB;
constexpr size_t WS_LOGF = 15 * MiB;
constexpr size_t WS_G = 15 * MiB + 512 * 1024;
constexpr size_t WS_U = 16 * MiB;
constexpr size_t WS_PROJ = 48 * MiB;
constexpr size_t WS_STASH = 176 * MiB;
constexpr size_t WS_END = 240 * MiB;
constexpr int CW_QUEUE = 0, CW_KMAX = 512, CW_TICK = 576, CW_BAR = 4096;
#ifndef USE_CG_SYNC
#define USE_CG_SYNC 0
#endif
constexpr size_t CTL_ROWSS = 65536;
constexpr int RING_BYTES = 131072, MISC_OFF = RING_BYTES, LDS_BYTES = 147456;
static_assert(att::ATT_BYTES <= RING_BYTES, "attention LDS map");

__device__ __forceinline__ unsigned f2bf(float f) { unsigned u = __builtin_bit_cast(unsigned, f); return (u + 0x7fffu + ((u >> 16) & 1u)) >> 16; }
__device__ __forceinline__ unsigned pk2(float lo, float hi) { return f2bf(lo) | (f2bf(hi) << 16); }
__device__ __forceinline__ float wave_sum(float v) {
#pragma unroll
    for (int o = 1; o < 64; o <<= 1) v += __shfl_xor(v, o);
    return v;
}
__device__ __forceinline__ int orig_col(int n) {
    const int g = n >> 9, wi = n & 511; const int base = g * 512 + (g >= 4 ? 8 : 0);
    if (g == 4 || g == 5) { const int head = wi >> 6, j = wi & 63; return base + head * 64 + (j >> 1) + 32 * (j & 1); }
    return base + wi;
}
__device__ __forceinline__ void transpose_item(const float* __restrict__ W, int ldw, int K, bf16* __restrict__ WT, LAS float* scr, int item, int nblk, int lane, bool permuted) {
    const int kb = item / nblk, nb = item % nblk, k0 = 64 * kb, n0 = 32 * nb;
    const int col = permuted ? orig_col(n0 + (lane & 31)) : n0 + (lane & 31);
#pragma unroll 8
    for (int i = 0; i < 32; ++i) { const int kk = 2 * i + (lane >> 5); scr[kk * 33 + (lane & 31)] = W[(size_t)(k0 + kk) * ldw + col]; }
    asm volatile("s_waitcnt lgkmcnt(0)" ::: "memory");
    const int c = lane & 7;
#pragma unroll
    for (int j = 0; j < 4; ++j) { const int n = (lane >> 3) + 8 * j; const LAS float* s = scr + (8 * c) * 33 + n;
        v4u o; o.x = pk2(s[0 * 33], s[1 * 33]); o.y = pk2(s[2 * 33], s[3 * 33]); o.z = pk2(s[4 * 33], s[5 * 33]); o.w = pk2(s[6 * 33], s[7 * 33]);
        *(v4u*)(WT + (size_t)(n0 + n) * K + k0 + 8 * c) = o; }
    asm volatile("s_waitcnt lgkmcnt(0)" ::: "memory");
}
__device__ const float ROPE_INVF[32] = {
    1.000000000e+00f, 7.498942018e-01f, 5.623413324e-01f, 4.216965139e-01f, 3.162277639e-01f, 2.371373773e-01f, 1.778279394e-01f, 1.333521456e-01f,
    1.000000015e-01f, 7.498942316e-02f, 5.623413250e-02f, 4.216964915e-02f, 3.162277490e-02f, 2.371373773e-02f, 1.778279431e-02f, 1.333521400e-02f,
    9.999999776e-03f, 7.498942316e-03f, 5.623413250e-03f, 4.216964822e-03f, 3.162277630e-03f, 2.371373819e-03f, 1.778279431e-03f, 1.333521446e-03f,
    1.000000047e-03f, 7.498941850e-04f, 5.623413017e-04f, 4.216965172e-04f, 3.162277571e-04f, 2.371373703e-04f, 1.778279402e-04f, 1.333521504e-04f };
__device__ __forceinline__ void sincos_acc(float ang, float& c, float& s) {
    const double x = (double)ang; const double kq = __builtin_rint(x * 0.63661977236758134308);
    double r = __builtin_fma(-kq, 1.57079632679489655800, x); r = __builtin_fma(-kq, 6.12323399573676603587e-17, r);
    const double r2 = r * r;
    double sp = -1.0 / 1307674368000.0; sp = sp * r2 + 1.0 / 6227020800.0; sp = sp * r2 - 1.0 / 39916800.0; sp = sp * r2 + 1.0 / 362880.0; sp = sp * r2 - 1.0 / 5040.0; sp = sp * r2 + 1.0 / 120.0; sp = sp * r2 - 1.0 / 6.0;
    const double sn = r + r * r2 * sp;
    double cp = 1.0 / 20922789888000.0; cp = cp * r2 - 1.0 / 87178291200.0; cp = cp * r2 + 1.0 / 479001600.0; cp = cp * r2 - 1.0 / 3628800.0; cp = cp * r2 + 1.0 / 40320.0; cp = cp * r2 - 1.0 / 720.0; cp = cp * r2 + 1.0 / 24.0; cp = cp * r2 - 0.5;
    const double cs = 1.0 + r2 * cp;
    const int q = ((int)kq) & 3;
    const double co = (q == 0) ? cs : (q == 1) ? -sn : (q == 2) ? -cs : sn;
    const double so = (q == 0) ? sn : (q == 1) ? cs : (q == 2) ? -sn : -cs;
    c = (float)co; s = (float)so;
}

struct Args { const float* in[11]; float* out; unsigned char* ws; int ph_lo, ph_hi; };

__global__ void __launch_bounds__(NWAVES * 64, 2) hymba_fwd(Args args) {
    extern __shared__ __attribute__((aligned(16))) unsigned char lds_raw[];
    LAS unsigned char* lds = (LAS unsigned char*)lds_raw;
    volatile LAS int* MISC = (volatile LAS int*)(lds + MISC_OFF);
    const int tid = threadIdx.x, lane = tid & 63, wave = __builtin_amdgcn_readfirstlane(tid >> 6);
    const int G = gridDim.x, bx = blockIdx.x;
    unsigned char* ws = args.ws;
    const float* x = args.in[0]; const float* norm_g = args.in[1]; const float* w_in = args.in[2]; const float* b_forget = args.in[3];
    const float* lq1 = args.in[4]; const float* lk1 = args.in[5]; const float* lq2 = args.in[6]; const float* lk2 = args.in[7];
    const float* subln_g = args.in[8]; const float* w_out = args.in[9]; const float* final_g = args.in[10];
    float* out = args.out;
    unsigned* ctl = (unsigned*)(ws + WS_CTL); float* rowss = (float*)(ws + WS_CTL + CTL_ROWSS);
    bf16* Wt_in = (bf16*)(ws + WS_WIN); bf16* Wt_out = (bf16*)(ws + WS_WOUT); float* rope = (float*)(ws + WS_ROPE);
    float* LOGF = (float*)(ws + WS_LOGF); float* GC = (float*)(ws + WS_G);
    bf16* U = (bf16*)(ws + WS_U); bf16* MIXED = (bf16*)(ws + WS_U); bf16* PROJ = (bf16*)(ws + WS_PROJ); float* STASH = (float*)(ws + WS_STASH);
    const int lo = args.ph_lo, hi_ph = args.ph_hi;
#ifndef PH_MASK
#define PH_MASK 31
#endif
#define IN(k) (((PH_MASK >> (k)) & 1) && lo <= (k) && (k) < hi_ph)
#if USE_CG_SYNC
#define GRID_SYNC(k) do { if (IN(k) && IN((k) + 1)) cg::this_grid().sync(); } while (0)
#else
    for (int u_ = tid; u_ < 64; u_ += NWAVES * 64) ((LAS unsigned*)(lds + MISC_OFF))[u_] = 0u;
    __syncthreads();
    XcdBarrier bar = xcd_barrier_post(ctl + CW_BAR, (volatile LAS unsigned*)(lds + MISC_OFF) + 8);
#define GRID_SYNC(k) do { if (IN(k) && IN((k) + 1)) xcd_barrier(bar); } while (0)
#endif

#ifndef PROBE
#define PROBE 0
#endif
    for (int rep_ = 0; rep_ < ((PROBE & 1) ? 2 : 1); ++rep_) {
    if (IN(0)) {
        const int gw = bx * NWAVES + wave, NGW = G * NWAVES;
        LAS float* scr = (LAS float*)(lds + wave * 16384);
        constexpr int I_IN = (DM / 64) * (NPROJ / 32), I_OUT = (DM / 64) * (DM / 32);
        for (int it = gw; it < I_IN + I_OUT; it += NGW) {
            if (it < I_IN) transpose_item(w_in, NCOL_IN, DM, Wt_in, scr, it, NPROJ / 32, lane, true);
            else transpose_item(w_out, DM, DM, Wt_out, scr, it - I_IN, DM / 32, lane, false);
        }
        for (int idx = bx * (NWAVES * 64) + tid; idx < SEQ * 32; idx += G * NWAVES * 64) {
            const int pos = idx >> 5, i = idx & 31; const float ang = (float)pos * ROPE_INVF[i]; float c, s; sincos_acc(ang, c, s);
            *(float2*)(rope + (size_t)idx * 2) = make_float2(c, s);
        }
        __syncthreads();
        LAS float* wfz = (LAS float*)lds;
        for (int k = tid; k < DM; k += NWAVES * 64) { const int j = k >> 8, l = (k & 255) >> 2, e = k & 3; const float* src = w_in + (size_t)k * NCOL_IN + 2048;
            const f32x4 a = *(const f32x4*)src, b = *(const f32x4*)(src + 4); LAS f32x4* d = (LAS f32x4*)(wfz + ((j * 4 + e) * 64 + l) * 8); d[0] = a; d[1] = b; }
        __syncthreads();
        f32x4 gv[4];
#pragma unroll
        for (int j = 0; j < 4; ++j) gv[j] = ((const f32x4*)norm_g)[lane + 64 * j];
        const float bz = b_forget[lane & 7];
        for (int m = gw; m < SEQ; m += NGW) {
            const f32x4* xr = (const f32x4*)(x + (size_t)m * DM) + lane;
            f32x4 v[4]; float s2 = 0.f;
#pragma unroll
            for (int j = 0; j < 4; ++j) { v[j] = xr[64 * j]; s2 += (v[j].x * v[j].x + v[j].y * v[j].y) + (v[j].z * v[j].z + v[j].w * v[j].w); }
            const float rstd = 1.0f / sqrtf(wave_sum(s2) * (1.0f / DM) + EPS);
            unsigned long long* o8 = (unsigned long long*)(U + (size_t)m * DM) + lane;
            float za[8];
#pragma unroll
            for (int c = 0; c < 8; ++c) za[c] = 0.f;
#pragma unroll
            for (int j = 0; j < 4; ++j) { v[j] = v[j] * rstd * gv[j];
                o8[64 * j] = (unsigned long long)pk2(v[j].x, v[j].y) | ((unsigned long long)pk2(v[j].z, v[j].w) << 32);
#pragma unroll
                for (int e = 0; e < 4; ++e) { const LAS f32x4* wp = (const LAS f32x4*)(wfz + ((j * 4 + e) * 64 + lane) * 8); const f32x4 wa = wp[0], wb = wp[1]; const float uv = v[j][e];
                    za[0] += uv * wa.x; za[1] += uv * wa.y; za[2] += uv * wa.z; za[3] += uv * wa.w; za[4] += uv * wb.x; za[5] += uv * wb.y; za[6] += uv * wb.z; za[7] += uv * wb.w; } }
#pragma unroll
            for (int c = 0; c < 8; ++c) za[c] = wave_sum(za[c]);
            const int c = lane & 7;
            float z = (c == 0) ? za[0] : (c == 1) ? za[1] : (c == 2) ? za[2] : (c == 3) ? za[3] : (c == 4) ? za[4] : (c == 5) ? za[5] : (c == 6) ? za[6] : za[7];
            z += bz;
            const float ls = (z >= 0.f) ? -log1pf(expf(-z)) : z - log1pf(expf(z));
            if (lane < 8) LOGF[(size_t)c * SEQ + m] = ls * LOG2E;
        }
    }
    GRID_SYNC(0);

    if (IN(1)) {
        if (bx < 8) {
            const float* lf = LOGF + (size_t)bx * SEQ + tid * 32; float* gc = GC + (size_t)bx * SEQ + tid * 32;
            double p[32]; double run = 0.0;
#pragma unroll
            for (int q = 0; q < 8; ++q) { const f32x4 a = ((const f32x4*)lf)[q];
                run += (double)a.x; p[4 * q] = run; run += (double)a.y; p[4 * q + 1] = run; run += (double)a.z; p[4 * q + 2] = run; run += (double)a.w; p[4 * q + 3] = run; }
            double sc = run;
#pragma unroll
            for (int o = 1; o < 64; o <<= 1) { const double n = __shfl_up(sc, o); if (lane >= o) sc += n; }
            LAS double* wt = (LAS double*)lds;
            if (lane == 63) wt[wave] = sc;
            __syncthreads();
            double base = sc - run;
            for (int q = 0; q < wave; ++q) base += wt[q];
#pragma unroll
            for (int q = 0; q < 8; ++q) { f32x4 o; o.x = (float)(base + p[4 * q]); o.y = (float)(base + p[4 * q + 1]); o.z = (float)(base + p[4 * q + 2]); o.w = (float)(base + p[4 * q + 3]); ((f32x4*)gc)[q] = o; }
            __syncthreads();
        }
        pg8::Gemm g{U, Wt_in, SEQ, NPROJ, DM}; pg8::StaticOrder S; S.init(SEQ, NPROJ, G, bx);
        pg8::EpiProj E{PROJ, rope, ctl + CW_KMAX};
        pg8::gemm_phase<pg8::EpiProj, pg8::StaticOrder, true, true>(lds, g, S, E);
    }
    GRID_SYNC(1);
    }

    if (IN(2)) {
        float lam;
        { int l_ = threadIdx.x & 63; asm volatile("" : "+v"(l_));
          const float lv = __expf(wave_sum(lq1[l_] * lk1[l_])) - __expf(wave_sum(lq2[l_] * lk2[l_])) + 0.2f;
          lam = __uint_as_float(__builtin_amdgcn_readfirstlane(__float_as_uint(lv))); }
        for (;;) {
            if (threadIdx.x == 0) MISC[0] = (int)atomicAdd(ctl + CW_QUEUE, 1u);
            __syncthreads();
            const int idx = MISC[0];
            __syncthreads();
            if (idx >= 1024) break;
            if (idx < 256) att::diff_unit(lds, MISC, PROJ, MIXED, STASH, ctl + CW_TICK, lam, subln_g, idx & 7, 63 - (idx >> 3));
            else if (idx < 768) att::fox_unit(lds, PROJ, GC, ctl + CW_KMAX, MIXED, (idx - 256) & 7, 63 - ((idx - 256) >> 3));
            else att::diff_unit(lds, MISC, PROJ, MIXED, STASH, ctl + CW_TICK, lam, subln_g, (idx - 768) & 7, 31 - ((idx - 768) >> 3));
        }
    }
    GRID_SYNC(2);

    if (IN(3)) {
        pg8::Gemm g{MIXED, Wt_out, SEQ, DM, DM}; pg8::StaticOrder S; S.init(SEQ, DM, G, bx);
        pg8::EpiOut E{x, out, rowss};
        pg8::gemm_phase<pg8::EpiOut, pg8::StaticOrder, false, true>(lds, g, S, E);
    }
    GRID_SYNC(3);

    if (IN(4)) {
        const int gw = bx * NWAVES + wave, NGW = G * NWAVES;
        f32x4 gv[4];
#pragma unroll
        for (int j = 0; j < 4; ++j) gv[j] = ((const f32x4*)final_g)[lane + 64 * j];
        for (int m = gw; m < SEQ; m += NGW) {
            const float rstd = 1.0f / sqrtf(rowss[m] * (1.0f / DM) + EPS);
            f32x4* hr = (f32x4*)(out + (size_t)m * DM) + lane;
#pragma unroll
            for (int j = 0; j < 4; ++j) hr[64 * j] = hr[64 * j] * rstd * gv[j];
        }
    }
#undef IN
#undef GRID_SYNC
}

extern "C" void kernel_launch(void* const* d_in, const int* in_sizes, int n_in, void* d_out, int out_size, void* d_ws, size_t ws_size, hipStream_t stream) {
    static int grid = 0;
    if (grid == 0) {
        if (n_in != 11 || in_sizes[0] != SEQ * DM || out_size != SEQ * DM || ws_size < WS_END) { fprintf(stderr, "kernel_launch: unexpected shapes (n_in %d, ws %zu)\n", n_in, ws_size); grid = -1; return; }
        int dev = 0, cus = 0, per_cu = 0;
        if (hipGetDevice(&dev) != hipSuccess || hipDeviceGetAttribute(&cus, hipDeviceAttributeMultiprocessorCount, dev) != hipSuccess) { grid = -1; return; }
        if (hipFuncSetAttribute((const void*)hymba_fwd, hipFuncAttributeMaxDynamicSharedMemorySize, LDS_BYTES) != hipSuccess) { fprintf(stderr, "kernel_launch: hipFuncSetAttribute failed\n"); grid = -1; return; }
        if (hipOccupancyMaxActiveBlocksPerMultiprocessor(&per_cu, (const void*)hymba_fwd, NWAVES * 64, LDS_BYTES) != hipSuccess || per_cu < 1) { fprintf(stderr, "kernel_launch: occupancy query says %d\n", per_cu); per_cu = 1; }
        (void)hipGetLastError();
        grid = cus;
    }
    if (grid < 0) return;
    (void)hipMemsetAsync((char*)d_ws + WS_CTL, 0, CTL_ZERO_BYTES, stream);
    Args a{};
    for (int i = 0; i < 11; ++i) a.in[i] = (const float*)d_in[i];
    a.out = (float*)d_out; a.ws = (unsigned char*)d_ws;
#if MK_N_LAUNCHES == 1
#if PROBE == 64
    a.ph_lo = 0; a.ph_hi = 2; hipLaunchKernelGGL(hymba_fwd, dim3(grid), dim3(NWAVES * 64), LDS_BYTES, stream, a);
    (void)hipMemsetAsync((char*)d_ws + WS_CTL, 0, CTL_ZERO_BYTES, stream);
#endif
    a.ph_lo = 0; a.ph_hi = 5;
    void* kargs[] = {&a};
#if USE_CG_SYNC
    hipError_t e = hipLaunchCooperativeKernel((const void*)hymba_fwd, dim3(grid), dim3(NWAVES * 64), kargs, LDS_BYTES, stream);
    if (e != hipSuccess) fprintf(stderr, "kernel_launch: cooperative launch failed: %s (grid %d)\n", hipGetErrorString(e), grid);
#else
    (void)kargs; hipLaunchKernelGGL(hymba_fwd, dim3(grid), dim3(NWAVES * 64), LDS_BYTES, stream, a);
#endif
#if PROBE == 128
    (void)hipMemsetAsync((char*)d_ws + WS_CTL, 0, CTL_ZERO_BYTES, stream);
    a.ph_lo = 3; a.ph_hi = 5; hipLaunchKernelGGL(hymba_fwd, dim3(grid), dim3(NWAVES * 64), LDS_BYTES, stream, a);
#endif
#else
    for (int ph = 0; ph < 5; ++ph) { a.ph_lo = ph; a.ph_hi = ph + 1; hipLaunchKernelGGL(hymba_fwd, dim3(grid), dim3(NWAVES * 64), LDS_BYTES, stream, a); }
#endif
}
```
